# Optimizing an MI355X kernel written in HIP

```python
import math
import jax, jax.numpy as jnp
from jax import lax
import numpy as np

D_MODEL = 1024
BATCH = 8
SEQ = 2048
DEPTH = 4

HEAD_DIM = 64
N_HEADS = 4
MIX_W = N_HEADS * HEAD_DIM
N_BRANCH = 4
Q_BLOCK = 128
EPS = 1e-6
NEG = -1e30
FORCE = 1e9
MLA_Q_LORA = 384
MLA_KV_LORA = 128
MLA_NOPE = 64
MLA_ROPE = 32
MLA_V = 64
MLA_QK = MLA_NOPE + MLA_ROPE
ROPE_THETA = 10000.0
NSA_CMP_LEN = 32
NSA_CMP_STRIDE = 16
NSA_SEL_LEN = 64
NSA_TOP_N = 16
NSA_WINDOW = 512
REL_BUCKETS = 32
REL_MAX_DIST = 128
D_FF = 4 * D_MODEL
PLE_DIM = 256
IN_WIDTHS = ((MIX_W,) * 3
             + (MLA_Q_LORA, MLA_KV_LORA, MLA_ROPE)
             + (MIX_W,) + (HEAD_DIM,) * 6 + (3 * N_HEADS,)
             + (MIX_W,) * 3 + (N_HEADS,)
             + (N_BRANCH * D_MODEL,))
N_IN = sum(IN_WIDTHS)

kernel_name = 'hybrid_sb_mla_nsa_fox_block'


def rmsnorm(x, g):
    x32 = x.astype(jnp.float32)
    y = x32 * lax.rsqrt(jnp.mean(x32 * x32, axis=-1, keepdims=True) + EPS)
    return (y * g.astype(jnp.float32)).astype(x.dtype)


def to_heads(t):
    B, S, _ = t.shape
    return t.reshape(B, S, N_HEADS, -1).transpose(0, 2, 1, 3)


def from_heads(t):
    B, H, S, Dh = t.shape
    return t.transpose(0, 2, 1, 3).reshape(B, S, H * Dh)


def unblock(o):
    nb, B, H, Qb, Dv = o.shape
    return o.transpose(1, 2, 0, 3, 4).reshape(B, H, nb * Qb, Dv)


def rel_bucket(dist):
    max_exact = REL_BUCKETS // 2
    d = jnp.maximum(dist, 0)
    large = max_exact + (jnp.log(jnp.maximum(d, 1).astype(jnp.float32) / max_exact)
                         / math.log(REL_MAX_DIST / max_exact)
                         * (REL_BUCKETS - max_exact)).astype(jnp.int32)
    large = jnp.minimum(large, REL_BUCKETS - 1)
    return jnp.where(d < max_exact, d, large)


def rope_tables(S):
    half = MLA_ROPE // 2
    inv = jnp.exp(-math.log(ROPE_THETA) * jnp.arange(half, dtype=jnp.float32) / half)
    ang = jnp.arange(S, dtype=jnp.float32)[:, None] * inv[None, :]
    return jnp.cos(ang), jnp.sin(ang)


def apply_rope(t, cos, sin):
    half = t.shape[-1] // 2
    t1, t2 = t[..., :half], t[..., half:]
    c = cos[None, :, None, :].astype(t.dtype)
    s = sin[None, :, None, :].astype(t.dtype)
    return jnp.concatenate([t1 * c - t2 * s, t2 * c + t1 * s], axis=-1)


def causal_softmax_attention(q, k, v, logit_bias):
    B, H, S, Dk = q.shape
    scale = Dk ** -0.5
    kpos = jnp.arange(S)

    def block(i):
        start = i * Q_BLOCK
        qb = lax.dynamic_slice_in_dim(q, start, Q_BLOCK, axis=2)
        s = jnp.einsum('bhqd,bhkd->bhqk', qb, k).astype(jnp.float32) * scale
        if logit_bias is not None:
            s = s + logit_bias(start)
        qpos = start + jnp.arange(Q_BLOCK)
        s = jnp.where(kpos[None, :] <= qpos[:, None], s, -jnp.inf)
        return jnp.einsum('bhqk,bhkd->bhqd', jax.nn.softmax(s, axis=-1).astype(v.dtype), v)

    return unblock(lax.map(block, jnp.arange(S // Q_BLOCK)))


def stick_breaking_attention(q, k, v):
    B, H, S, Dh = q.shape
    scale = Dh ** -0.5
    kpos = jnp.arange(S)

    def block(i):
        start = i * Q_BLOCK
        qb = lax.dynamic_slice_in_dim(q, start, Q_BLOCK, axis=2)
        z = jnp.einsum('bhqd,bhkd->bhqk', qb, k).astype(jnp.float32) * scale
        qpos = start + jnp.arange(Q_BLOCK)
        past = kpos[None, :] < qpos[:, None]
        log_1m = jnp.where(past, jax.nn.log_sigmoid(-z), 0.0)
        between = lax.cumsum(log_1m, axis=3, reverse=True) - log_1m
        w = jnp.where(past, jnp.exp(jax.nn.log_sigmoid(z) + between), 0.0)
        return jnp.einsum('bhqk,bhkd->bhqd', w.astype(v.dtype), v)

    return unblock(lax.map(block, jnp.arange(S // Q_BLOCK)))


def mla_mixer(c_q, c_kv, k_rope, cq_g, ckv_g, w_uq, w_ukv, qn_g, kn_g):
    B, S, _ = c_q.shape
    q = (rmsnorm(c_q, cq_g) @ w_uq).reshape(B, S, N_HEADS, MLA_QK)
    kv = (rmsnorm(c_kv, ckv_g) @ w_ukv).reshape(B, S, N_HEADS, MLA_NOPE + MLA_V)
    k_nope, v = kv[..., :MLA_NOPE], kv[..., MLA_NOPE:]
    k = jnp.concatenate([k_nope, jnp.broadcast_to(k_rope[:, :, None, :], (B, S, N_HEADS, MLA_ROPE))], axis=-1)
    q = rmsnorm(q, qn_g)
    k = rmsnorm(k, kn_g)
    cos, sin = rope_tables(S)
    q = jnp.concatenate([q[..., :MLA_NOPE], apply_rope(q[..., MLA_NOPE:], cos, sin)], axis=-1)
    k = jnp.concatenate([k[..., :MLA_NOPE], apply_rope(k[..., MLA_NOPE:], cos, sin)], axis=-1)
    o = causal_softmax_attention(q.transpose(0, 2, 1, 3), k.transpose(0, 2, 1, 3),
                                 v.transpose(0, 2, 1, 3), None)
    return from_heads(o)


def nsa_mixer(q, k_cmp, v_cmp, k_slc, v_slc, k_win, v_win, g_logit,
              pe_k, pe_v, w1_k, w2_k, w1_v, w2_v, qn_g, kn_g, rel_bias):
    B, S, _ = q.shape
    Dh = HEAD_DIM
    scale = Dh ** -0.5
    q = rmsnorm(to_heads(q), qn_g)
    tpos = jnp.arange(S)
    table = rel_bias.astype(jnp.float32)

    n_cmp = (S - NSA_CMP_LEN) // NSA_CMP_STRIDE + 1
    starts = jnp.arange(n_cmp) * NSA_CMP_STRIDE
    gidx = starts[:, None] + jnp.arange(NSA_CMP_LEN)[None, :]

    def compress(t, pe, w1, w2):
        blocks = (t[:, gidx, :] + pe).reshape(B, n_cmp, NSA_CMP_LEN * Dh)
        return jax.nn.silu(blocks @ w1) @ w2

    kc = rmsnorm(compress(k_cmp, pe_k, w1_k, w2_k), kn_g[0])
    vc = compress(v_cmp, pe_v, w1_v, w2_v)
    cmp_dist = tpos[:, None] - (starts + NSA_CMP_LEN - 1)[None, :]
    cmp_valid = cmp_dist >= 0
    s_c = (jnp.einsum('bhsd,bcd->bhsc', q, kc).astype(jnp.float32) * scale
           + table[rel_bucket(cmp_dist)].transpose(2, 0, 1)[None])
    p_c = jax.nn.softmax(jnp.where(cmp_valid, s_c, NEG), axis=-1)
    p_c = jnp.where(cmp_valid, p_c, 0.0)
    o_cmp = jnp.einsum('bhsc,bcd->bhsd', p_c.astype(vc.dtype), vc)

    n_sel = S // NSA_SEL_LEN
    c0 = starts[:, None]
    j0 = (jnp.arange(n_sel) * NSA_SEL_LEN)[None, :]
    overlap = ((c0 < j0 + NSA_SEL_LEN) & (c0 + NSA_CMP_LEN > j0)).astype(jnp.float32)
    imp = jnp.einsum('bhsc,cj->bsj', p_c, overlap)
    blk = jnp.arange(n_sel)[None, :]
    cur = (tpos // NSA_SEL_LEN)[:, None]
    forced = (blk == 0) | (blk == cur) | (blk == cur - 1)
    imp = jnp.where(forced, FORCE, imp)
    imp = jnp.where(blk <= cur, imp, -FORCE)
    top_n = min(NSA_TOP_N, n_sel)
    _, sel = lax.top_k(imp, top_n)

    ks = rmsnorm(k_slc, kn_g[1])
    kw = rmsnorm(k_win, kn_g[2])
    kw_pad = jnp.pad(kw, ((0, 0), (NSA_WINDOW, 0), (0, 0)))
    vw_pad = jnp.pad(v_win, ((0, 0), (NSA_WINDOW, 0), (0, 0)))
    bidx = jnp.arange(B)[:, None, None]
    offs = jnp.arange(NSA_SEL_LEN)
    n_keys = top_n * NSA_SEL_LEN

    def block(i):
        start = i * Q_BLOCK
        qb = lax.dynamic_slice_in_dim(q, start, Q_BLOCK, axis=2)
        qpos = start + jnp.arange(Q_BLOCK)
        sb = lax.dynamic_slice_in_dim(sel, start, Q_BLOCK, axis=1)
        kpos = (sb[..., None] * NSA_SEL_LEN + offs).reshape(B, Q_BLOCK, n_keys)
        kg = ks[bidx, kpos]
        vg = v_slc[bidx, kpos]
        dist = qpos[None, :, None] - kpos
        s = (jnp.einsum('bhqd,bqkd->bhqk', qb, kg).astype(jnp.float32) * scale
             + table[rel_bucket(dist)].transpose(0, 3, 1, 2))
        s = jnp.where((dist >= 0)[:, None], s, -jnp.inf)
        o_s = jnp.einsum('bhqk,bqkd->bhqd', jax.nn.softmax(s, axis=-1).astype(vg.dtype), vg)
        kb = lax.dynamic_slice_in_dim(kw_pad, start, NSA_WINDOW + Q_BLOCK, axis=1)
        vb = lax.dynamic_slice_in_dim(vw_pad, start, NSA_WINDOW + Q_BLOCK, axis=1)
        wpos = start - NSA_WINDOW + jnp.arange(NSA_WINDOW + Q_BLOCK)
        wdist = qpos[:, None] - wpos[None, :]
        wmask = (wdist >= 0) & (wdist < NSA_WINDOW) & (wpos[None, :] >= 0)
        s_w = (jnp.einsum('bhqd,bkd->bhqk', qb, kb).astype(jnp.float32) * scale
               + table[rel_bucket(wdist)].transpose(2, 0, 1)[None])
        s_w = jnp.where(wmask, s_w, -jnp.inf)
        o_w = jnp.einsum('bhqk,bkd->bhqd', jax.nn.softmax(s_w, axis=-1).astype(vb.dtype), vb)
        return o_s, o_w

    o_slc, o_win = lax.map(block, jnp.arange(S // Q_BLOCK))
    o_slc = unblock(o_slc)
    o_win = unblock(o_win)
    g = jax.nn.sigmoid(g_logit.astype(jnp.float32)).reshape(B, S, 3, N_HEADS).transpose(2, 0, 3, 1)[..., None]
    o = g[0] * o_cmp + g[1] * o_slc + g[2] * o_win
    return from_heads(o.astype(q.dtype))


def fox_mixer(q, k, v, f_logit, f_bias, qn_g, kn_g):
    q = rmsnorm(to_heads(q), qn_g)
    k = rmsnorm(to_heads(k), kn_g)
    v = to_heads(v)
    log_f = jax.nn.log_sigmoid(f_logit.astype(jnp.float32) + f_bias.astype(jnp.float32))
    cum = lax.cumsum(log_f, axis=1).transpose(0, 2, 1)

    def decay_bias(start):
        cq = lax.dynamic_slice_in_dim(cum, start, Q_BLOCK, axis=2)
        return cq[..., :, None] - cum[..., None, :]

    return from_heads(causal_softmax_attention(q, k, v, decay_bias))


def setup_inputs(seed: int = 0) -> dict:
    key = jax.random.key(seed)
    keys = list(jax.random.split(key, 40))
    f32 = jnp.float32

    def nrm(shape, scale):
        return scale * jax.random.normal(keys.pop(), shape, f32)

    def gain(shape):
        return 1.0 + 0.05 * jax.random.normal(keys.pop(), shape, f32)

    L = DEPTH
    cmp_in = NSA_CMP_LEN * HEAD_DIM
    return {
        'x': nrm((BATCH, SEQ, D_MODEL), 1.0),
        'p': nrm((DEPTH, BATCH, SEQ, PLE_DIM), 1.0),
        'rel_bias': nrm((REL_BUCKETS, N_HEADS), 0.5),
        'norm_mix_g': gain((L, D_MODEL)),
        'w_in': nrm((L, D_MODEL, N_IN), D_MODEL ** -0.5),
        'mla_cq_norm_g': gain((L, MLA_Q_LORA)),
        'mla_ckv_norm_g': gain((L, MLA_KV_LORA)),
        'mla_w_uq': nrm((L, MLA_Q_LORA, N_HEADS * MLA_QK), MLA_Q_LORA ** -0.5),
        'mla_w_ukv': nrm((L, MLA_KV_LORA, N_HEADS * (MLA_NOPE + MLA_V)), MLA_KV_LORA ** -0.5),
        'mla_qn_g': gain((L, MLA_QK)),
        'mla_kn_g': gain((L, MLA_QK)),
        'nsa_pe_k': nrm((L, NSA_CMP_LEN, HEAD_DIM), 0.1),
        'nsa_pe_v': nrm((L, NSA_CMP_LEN, HEAD_DIM), 0.1),
        'nsa_w1_k': nrm((L, cmp_in, HEAD_DIM), cmp_in ** -0.5),
        'nsa_w2_k': nrm((L, HEAD_DIM, HEAD_DIM), HEAD_DIM ** -0.5),
        'nsa_w1_v': nrm((L, cmp_in, HEAD_DIM), cmp_in ** -0.5),
        'nsa_w2_v': nrm((L, HEAD_DIM, HEAD_DIM), HEAD_DIM ** -0.5),
        'nsa_qn_g': gain((L, HEAD_DIM)),
        'nsa_kn_g': gain((L, 3, HEAD_DIM)),
        'fox_f_bias': 2.0 + nrm((L, N_HEADS), 0.5),
        'fox_qn_g': gain((L, HEAD_DIM)),
        'fox_kn_g': gain((L, HEAD_DIM)),
        'w_branch': nrm((L, N_BRANCH, MIX_W, D_MODEL), MIX_W ** -0.5),
        'w_o': nrm((L, D_MODEL, D_MODEL), D_MODEL ** -0.5),
        'norm_mlp_g': gain((L, D_MODEL)),
        'w_mlp_up': nrm((L, D_MODEL, D_FF), D_MODEL ** -0.5),
        'w_mlp_down': nrm((L, D_FF, D_MODEL), D_FF ** -0.5),
        'norm_ple_g': gain((L, D_MODEL)),
        'w_ple_gate': nrm((L, D_MODEL, D_MODEL), D_MODEL ** -0.5),
        'w_ple_proj': nrm((L, PLE_DIM, D_MODEL), PLE_DIM ** -0.5),
    }


def reference(x, p, rel_bias, norm_mix_g, w_in, mla_cq_norm_g, mla_ckv_norm_g,
              mla_w_uq, mla_w_ukv, mla_qn_g, mla_kn_g, nsa_pe_k, nsa_pe_v,
              nsa_w1_k, nsa_w2_k, nsa_w1_v, nsa_w2_v, nsa_qn_g, nsa_kn_g,
              fox_f_bias, fox_qn_g, fox_kn_g, w_branch, w_o, norm_mlp_g,
              w_mlp_up, w_mlp_down, norm_ple_g, w_ple_gate, w_ple_proj):
    B, S, _ = x.shape
    offsets = np.cumsum(IN_WIDTHS)[:-1].tolist()
    for i in range(DEPTH):
        h = rmsnorm(x, norm_mix_g[i])
        (sb_q, sb_k, sb_v, mla_cq, mla_ckv, mla_kr,
         nsa_q, nsa_kc, nsa_vc, nsa_ks, nsa_vs, nsa_kw, nsa_vw, nsa_g,
         fox_q, fox_k, fox_v, fox_f, gate_logits) = jnp.split(h @ w_in[i], offsets, axis=-1)

        y_sb = from_heads(stick_breaking_attention(to_heads(sb_q), to_heads(sb_k), to_heads(sb_v)))
        y_mla = mla_mixer(mla_cq, mla_ckv, mla_kr, mla_cq_norm_g[i], mla_ckv_norm_g[i],
                          mla_w_uq[i], mla_w_ukv[i], mla_qn_g[i], mla_kn_g[i])
        y_nsa = nsa_mixer(nsa_q, nsa_kc, nsa_vc, nsa_ks, nsa_vs, nsa_kw, nsa_vw, nsa_g,
                          nsa_pe_k[i], nsa_pe_v[i], nsa_w1_k[i], nsa_w2_k[i],
                          nsa_w1_v[i], nsa_w2_v[i], nsa_qn_g[i], nsa_kn_g[i], rel_bias)
        y_fox = fox_mixer(fox_q, fox_k, fox_v, fox_f, fox_f_bias[i], fox_qn_g[i], fox_kn_g[i])

        branches = jnp.stack([y_sb, y_mla, y_nsa, y_fox], axis=2)
        widened = jnp.einsum('bsnc,ncd->bsnd', branches, w_branch[i])
        gates = jax.nn.sigmoid(gate_logits.reshape(B, S, N_BRANCH, D_MODEL))
        x = x + jnp.einsum('bsnd,de->bse', gates * widened, w_o[i])

        h2 = rmsnorm(x, norm_mlp_g[i])
        x = x + jnp.square(jax.nn.relu(h2 @ w_mlp_up[i])) @ w_mlp_down[i]

        ple_gate = jax.nn.sigmoid(rmsnorm(x, norm_ple_g[i]) @ w_ple_gate[i])
        x = x + ple_gate * (p[i] @ w_ple_proj[i])
    return x
```

```cpp
#include <hip/hip_runtime.h>
#include <hip/hip_cooperative_groups.h>
#include <cstdio>
#include <cstdint>
#include <cstring>
namespace cg = cooperative_groups;

#ifndef FUSE_MASK
#define FUSE_MASK 1
#endif
#ifndef MULTI
#define MULTI 0
#endif

typedef unsigned short bfu;
using bf16x8 = __attribute__((ext_vector_type(8))) short;
using s16x4  = __attribute__((ext_vector_type(4))) short;
using f32x16 = __attribute__((ext_vector_type(16))) float;
using u32x4  = __attribute__((ext_vector_type(4))) unsigned;
using u32x2  = __attribute__((ext_vector_type(2))) unsigned;
#define DI __device__ __forceinline__
#define MFMA(a, b, c) __builtin_amdgcn_mfma_f32_32x32x16_bf16((a), (b), (c), 0, 0, 0)

constexpr int NB = 8, S = 2048, D = 1024, M = NB * S, H = 4;
constexpr int NIN = 6832, NINP = 6912, PJ = 2752, PJN = 2736;
constexpr int DFF = 4096;
constexpr float EPS = 1e-6f;
constexpr int SMEM_BYTES = 60 * 1024;
constexpr int NPH = 10;

struct Params {
  const float *x, *p, *rel_bias, *norm_mix_g, *w_in, *mla_cq_g, *mla_ckv_g, *mla_w_uq, *mla_w_ukv, *mla_qn_g, *mla_kn_g;
  const float *nsa_pe_k, *nsa_pe_v, *nsa_w1_k, *nsa_w2_k, *nsa_w1_v, *nsa_w2_v, *nsa_qn_g, *nsa_kn_g;
  const float *fox_f_bias, *fox_qn_g, *fox_kn_g, *w_branch, *w_o, *norm_mlp_g, *w_up, *w_down, *norm_ple_g, *w_ple_gate, *w_ple_proj;
  float* out;
  bfu *wt_in, *wt_uq, *wt_ukv, *wt_br, *wt_o, *wt_up, *wt_down, *wt_pg, *wt_pp;
  bfu *xb, *xb2, *krope, *pb, *kcmp, *vcmp, *wt_w1, *kc_b, *vct_b, *cq, *ckv, *proj, *gates, *ff, *y, *u, *qraw, *kvraw;
  float* small_;
  bfu *q_sb, *k_sb, *vt_sb, *q_fox, *k_fox, *vt_fox, *q_nsa, *ks, *vts, *kw, *vtw, *q_mla, *k_mla, *vt_mla;
  float *cum, *kc, *vc, *ocmp, *pebias;
  unsigned* selmask;
  int ph_lo, ph_hi;
  unsigned* bar;
};

DI int TID() { int t = threadIdx.x; asm volatile("" : "+v"(t)); return t; }
DI bfu f2bf(float f) { __bf16 h = (__bf16)f; return __builtin_bit_cast(bfu, h); }
DI float bf2f(bfu b) { return __uint_as_float(((unsigned)b) << 16); }
typedef float f32x2_t __attribute__((ext_vector_type(2)));
typedef __bf16 bf16x2_t __attribute__((ext_vector_type(2)));
DI unsigned pk2(float a, float b) { f32x2_t v = {a, b}; bf16x2_t r_ = __builtin_convertvector(v, bf16x2_t); return __builtin_bit_cast(unsigned, r_); }
DI float bflo(unsigned u) { return __uint_as_float(u << 16); }
DI float bfhi(unsigned u) { return __uint_as_float(u & 0xffff0000u); }
DI float sigmoidf_(float v) { return 1.f / (1.f + __expf(-v)); }

#define PACK8(vec, base) __builtin_bit_cast(bf16x8, (u32x4){pk2((vec)[(base)+0], (vec)[(base)+1]), pk2((vec)[(base)+2], (vec)[(base)+3]), pk2((vec)[(base)+4], (vec)[(base)+5]), pk2((vec)[(base)+6], (vec)[(base)+7])})

DI int in_colmap(int n) {
  if (n < 1280) return n;
  if (n < 1920) return n + 32;
  if (n < 2688) return n + 44;
  if (n < 2720) return n - 2688 + 1280;
  if (n < 2732) return n - 2720 + 1952;
  if (n < 2736) return n;
  if (n < 2752) return -1;
  if (n < 6848) return n - 16;
  return -1;
}
template <bool MAP = false>
DI void conv_tile(const float* __restrict__ src, int N, int K, bfu* __restrict__ dst, const float* __restrict__ g,
                  int tk, int tn, char* smem, int ldk = -1) {
  const int LK = ldk < 0 ? K : ldk;
  float* T = (float*)smem;
  const int tid = TID();
  __syncthreads();
#pragma unroll
  for (int j = 0; j < 4; ++j) {
    int k = (tid >> 4) + 16 * j, n4 = (tid & 15) * 4;
    int gn = tn * 64 + n4, gk = tk * 64 + k;
    float4 v = make_float4(0.f, 0.f, 0.f, 0.f);
    const int og = MAP ? in_colmap(gn) : (gn < N ? gn : -1);
    if (og >= 0) v = *(const float4*)(src + (size_t)gk * N + og);
    float gg = g ? g[gk] : 1.f;
    T[k * 65 + n4 + 0] = v.x * gg; T[k * 65 + n4 + 1] = v.y * gg; T[k * 65 + n4 + 2] = v.z * gg; T[k * 65 + n4 + 3] = v.w * gg;
  }
  __syncthreads();
#pragma unroll
  for (int j = 0; j < 2; ++j) {
    int n = (tid >> 3) + 32 * j, kc = tid & 7;
    float e[8];
#pragma unroll
    for (int q = 0; q < 8; ++q) e[q] = T[(kc * 8 + q) * 65 + n];
    u32x4 o = {pk2(e[0], e[1]), pk2(e[2], e[3]), pk2(e[4], e[5]), pk2(e[6], e[7])};
    *(u32x4*)(dst + (size_t)(tn * 64 + n) * LK + tk * 64 + kc * 8) = o;
  }
}

constexpr int CV_NA = 16 * 108, CV_NB = 36 + 16 + 128 + 16, CV_NC = 256 + 256 + 1024 + 1024 + 256 + 64 + 2048, CV_NX = M * D / 2048;
DI void conv_item_A(const Params& p, int L, int t, char* smem) {
  conv_tile<true>(p.w_in + (size_t)L * D * NIN, NIN, D, p.wt_in, p.norm_mix_g + L * D, t / 108, t % 108, smem);
}
DI void conv_item_B(const Params& p, int L, int it, char* smem) {
  if (it < 36) { conv_tile(p.mla_w_uq + (size_t)L * 384 * 384, 384, 384, p.wt_uq, p.mla_cq_g + L * 384, it / 6, it % 6, smem); }
  else if (it < 52) { int t = it - 36; conv_tile(p.mla_w_ukv + (size_t)L * 128 * 512, 512, 128, p.wt_ukv, p.mla_ckv_g + L * 128, t / 8, t % 8, smem); }
  else if (it < 180) { int t = it - 52; int kv = t >> 6; t &= 63;
    conv_tile((kv ? p.nsa_w1_v : p.nsa_w1_k) + (size_t)L * 2048 * 64, 64, 2048, p.wt_w1 + (size_t)kv * 128 * 2048, nullptr, t >> 1, t & 1, smem); }
  else {
    const int q = it - 180; const int kv = q >> 3, kr = q & 7; const int tid = TID(); const int n = tid & 63, kq = tid >> 6;
    const float* w1 = (kv ? p.nsa_w1_v : p.nsa_w1_k) + (size_t)L * 2048 * 64;
    const float* pe = (kv ? p.nsa_pe_v : p.nsa_pe_k) + (size_t)L * 2048;
    float a = 0.f;
    const int kb = kr * 256 + kq * 64;
#pragma unroll 16
    for (int k = kb; k < kb + 64; ++k) a += pe[k] * w1[(size_t)k * 64 + n];
    float* red = (float*)smem;
    __syncthreads(); red[tid] = a; __syncthreads();
    if (tid < 64) p.pebias[(kv * 8 + kr) * 64 + tid] = (red[tid] + red[tid + 64]) + (red[tid + 128] + red[tid + 192]);
  }
}
DI void conv_item_C(const Params& p, int L, int it, char* smem) {
  if (it < 256) { int t = it; int n = t >> 6; t &= 63; conv_tile(p.w_branch + ((size_t)L * 4 + n) * 256 * D, D, 256, p.wt_br + (size_t)n * 256, nullptr, t / 16, t % 16, smem, 1024); }
  else if (it < 512) { int t = it - 256; conv_tile(p.w_o + (size_t)L * D * D, D, D, p.wt_o, nullptr, t / 16, t % 16, smem); }
  else if (it < 1536) { int t = it - 512; conv_tile(p.w_up + (size_t)L * D * DFF, DFF, D, p.wt_up, p.norm_mlp_g + L * D, t / 64, t % 64, smem); }
  else if (it < 2560) { int t = it - 1536; conv_tile(p.w_down + (size_t)L * DFF * D, D, DFF, p.wt_down, nullptr, t / 16, t % 16, smem); }
  else if (it < 2816) { int t = it - 2560; conv_tile(p.w_ple_gate + (size_t)L * D * D, D, D, p.wt_pg, p.norm_ple_g + L * D, t / 16, t % 16, smem); }
  else if (it < 2880) { int t = it - 2816; conv_tile(p.w_ple_proj + (size_t)L * 256 * D, D, 256, p.wt_pp, nullptr, t / 16, t % 16, smem); }
  else {
    size_t e = (size_t)(it - 2880) * 2048 + TID() * 8;
    const float* sp = p.p + (size_t)L * M * 256 + e;
    float4 a = *(const float4*)sp, b = *(const float4*)(sp + 4);
    *(u32x4*)(p.pb + e) = (u32x4){pk2(a.x, a.y), pk2(a.z, a.w), pk2(b.x, b.y), pk2(b.z, b.w)};
  }
}
DI void phase_convert(const Params& p, int L, char* smem) {
  const int total = CV_NA + CV_NB + CV_NC + CV_NX;
  for (int it = blockIdx.x; it < total; it += gridDim.x) {
    if (it < CV_NA) conv_item_A(p, L, it, smem);
    else if (it < CV_NA + CV_NB) conv_item_B(p, L, it - CV_NA, smem);
    else if (it < CV_NA + CV_NB + CV_NC) conv_item_C(p, L, it - CV_NA - CV_NB, smem);
    else {
      size_t e = (size_t)(it - CV_NA - CV_NB - CV_NC) * 2048 + TID() * 8;
      float4 a = *(const float4*)(p.x + e), b = *(const float4*)(p.x + e + 4);
      *(float4*)(p.out + e) = a; *(float4*)(p.out + e + 4) = b;
      *(u32x4*)(p.xb2 + e) = (u32x4){pk2(a.x, a.y), pk2(a.z, a.w), pk2(b.x, b.y), pk2(b.z, b.w)};
    }
  }
}

#define BAR_LDS() do { asm volatile("s_waitcnt lgkmcnt(0)" ::: "memory"); __builtin_amdgcn_s_barrier(); asm volatile("" ::: "memory"); } while (0)
constexpr int GP = 72;
constexpr int RSTD_OFF = 55296;
struct NoHook { DI void operator()(int) const {} };
template <bool NORM, bool DEEP, int MTW, int KSEG, class HOOK>
DI void gemm_core_h(const bfu* __restrict__ A, int lda, const bfu* __restrict__ Bt, int ldb, int K, int m0, int n0,
                    f32x16 (&acc)[MTW][2], char* smem, HOOK hook) {
  constexpr int NA = 2 * MTW;
  bfu* As = (bfu*)smem;
  bfu* Bs = As + 64 * MTW * GP;
  float* rstd_s = (float*)(smem + RSTD_OFF);
  const int tid = TID(), lane = tid & 63, w = tid >> 6, r = lane & 31, hh = lane >> 5;
  const int wm = w >> 1, wn = w & 1;
  const int lrow = tid >> 3, lkc = tid & 7;
  const unsigned aoff = (unsigned)((m0 + lrow) * lda + lkc * 8);
  const unsigned boff = (unsigned)((n0 + lrow) * ldb + lkc * 8);
#define AP_(j, k64) (A + (aoff + (unsigned)(32 * (j)) * (unsigned)lda + (unsigned)(k64)))
#define BP_(j, k64) (Bt + (boff + (unsigned)(32 * (j)) * (unsigned)ldb + (unsigned)(k64)))
  u32x4 ra0[NA], rb0[4], ra1[NA], rb1[4];
  float ssq[NA];
#pragma unroll
  for (int j = 0; j < NA; ++j) ssq[j] = 0.f;
  const int nk = K >> 6;
#pragma unroll
  for (int j = 0; j < NA; ++j) ra0[j] = *(const u32x4*)AP_(j, 0);
#pragma unroll
  for (int j = 0; j < 4; ++j) rb0[j] = *(const u32x4*)BP_(j, 0);
  if (DEEP) {
#pragma unroll
    for (int j = 0; j < NA; ++j) ra1[j] = *(const u32x4*)AP_(j, 64);
#pragma unroll
    for (int j = 0; j < 4; ++j) rb1[j] = *(const u32x4*)BP_(j, 64);
  }
#define GEMM_STEP(RA, RB, KT, DIST)                                                                                \
  {                                                                                                                \
    BAR_LDS();                                                                                                     \
    _Pragma("unroll") for (int j = 0; j < NA; ++j) *(u32x4*)(As + (lrow + 32 * j) * GP + lkc * 8) = RA[j];         \
    _Pragma("unroll") for (int j = 0; j < 4; ++j) *(u32x4*)(Bs + (lrow + 32 * j) * GP + lkc * 8) = RB[j];          \
    if (NORM) {                                                                                                    \
      _Pragma("unroll") for (int j = 0; j < NA; ++j) _Pragma("unroll") for (int e = 0; e < 4; ++e) {               \
        float lo = bflo(RA[j][e]), hi = bfhi(RA[j][e]); ssq[j] += lo * lo + hi * hi; }                             \
    }                                                                                                              \
    BAR_LDS();                                                                                                     \
    {                                                                                                              \
      const int kn_ = ((KT) + (DIST) < nk) ? ((KT) + (DIST)) : (nk - 1);       \
      _Pragma("unroll") for (int j = 0; j < NA; ++j) RA[j] = *(const u32x4*)AP_(j, kn_ * 64);                      \
      _Pragma("unroll") for (int j = 0; j < 4; ++j) RB[j] = *(const u32x4*)BP_(j, kn_ * 64);                       \
    }                                                                                                              \
    _Pragma("unroll") for (int ks = 0; ks < 4; ++ks) {                                                             \
      bf16x8 b0 = *(const bf16x8*)(Bs + (wn * 64 + r) * GP + ks * 16 + hh * 8);                                    \
      bf16x8 b1 = *(const bf16x8*)(Bs + (wn * 64 + 32 + r) * GP + ks * 16 + hh * 8);                               \
      _Pragma("unroll") for (int mt = 0; mt < MTW; ++mt) {                                                         \
        bf16x8 a_ = *(const bf16x8*)(As + (wm * 32 * MTW + mt * 32 + r) * GP + ks * 16 + hh * 8);                  \
        acc[mt][0] = MFMA(a_, b0, acc[mt][0]); acc[mt][1] = MFMA(a_, b1, acc[mt][1]);                              \
      }                                                                                                            \
    }                                                                                                              \
  }
  if (DEEP) {
    for (int kt = 0; kt < nk; kt += 2) {
      GEMM_STEP(ra0, rb0, kt, 2)
      GEMM_STEP(ra1, rb1, kt + 1, 2)
      if (KSEG > 0) { if (((kt + 2) % (KSEG > 0 ? KSEG : 2)) == 0) hook((kt + 2) / (KSEG > 0 ? KSEG : 2) - 1); }
    }
  } else {
    for (int kt = 0; kt < nk; ++kt) {
      GEMM_STEP(ra0, rb0, kt, 1)
      if (KSEG > 0) { if (((kt + 1) % (KSEG > 0 ? KSEG : 1)) == 0) hook((kt + 1) / (KSEG > 0 ? KSEG : 1) - 1); }
    }
  }
#undef GEMM_STEP
#undef AP_
#undef BP_
  if (NORM) {
#pragma unroll
    for (int j = 0; j < NA; ++j) {
      float v = ssq[j];
      v += __shfl_xor(v, 1); v += __shfl_xor(v, 2); v += __shfl_xor(v, 4);
      if (lkc == 0) rstd_s[lrow + 32 * j] = rsqrtf(v / (float)K + EPS);
    }
  }
  __syncthreads();
}

template <bool NORM, bool DEEP = true, int MTW = 2>
DI void gemm_core(const bfu* __restrict__ A, int lda, const bfu* __restrict__ Bt, int ldb, int K, int m0, int n0,
                  f32x16 (&acc)[MTW][2], char* smem) {
  gemm_core_h<NORM, DEEP, MTW, 0, NoHook>(A, lda, Bt, ldb, K, m0, n0, acc, smem, NoHook());
}

#define ZERO_ACC(a) ZERO_ACCM(a, 2)
#define ZERO_ACCM(a, MT) _Pragma("unroll") for (int _m = 0; _m < MT; ++_m) _Pragma("unroll") for (int _n = 0; _n < 2; ++_n) _Pragma("unroll") for (int _i = 0; _i < 16; ++_i) a[_m][_n][_i] = 0.f;

#define EPI_BEGIN(accv) EPI_BEGINM(accv, 2)
#define EPI_BEGINM(accv, MT)                                                                                    \
  _Pragma("unroll") for (int mt = 0; mt < MT; ++mt) _Pragma("unroll") for (int nt = 0; nt < 2; ++nt)              \
  _Pragma("unroll") for (int i = 0; i < 16; ++i) {                                                              \
    const int rl = wm * 32 * MT + mt * 32 + (i & 3) + 8 * (i >> 2) + 4 * hh;                                      \
    const int row = m0 + rl; const int col = n0 + wn * 64 + nt * 32 + r; float v = accv[mt][nt][i];               \
    (void)rl; (void)row; (void)col; (void)v;
#define EPI_END }

#define GEMM_IDS const int tid = TID(), lane = tid & 63, w = tid >> 6, r = lane & 31, hh = lane >> 5, wm = w >> 1, wn = w & 1; \
  const float* rstd_s = (const float*)(smem + RSTD_OFF); (void)rstd_s; (void)r; (void)hh; (void)wm; (void)wn;

DI void map_tile(int id, int NT, int& mt, int& nt) {
  int x = id & 7, idx = id >> 3;
  int srl = idx / (8 * NT), rem = idx % (8 * NT);
  nt = rem >> 3; int mi = rem & 7;
  mt = (srl * 8 + x) * 8 + mi;
}

#define STORE_TILE_BF16(accv, MT, BASE, LD, COLOFF, OP)                                                           \
  _Pragma("unroll") for (int mt = 0; mt < MT; ++mt) _Pragma("unroll") for (int ip = 0; ip < 8; ++ip) {             \
    const int i0 = 2 * ip;                                                                                        \
    const int rl0 = wm * 32 * MT + mt * 32 + (i0 & 3) + 8 * (i0 >> 2) + 4 * hh;                                    \
    const float rs0 = rstd_s[rl0], rs1 = rstd_s[rl0 + 1]; (void)rs0; (void)rs1;                                    \
    _Pragma("unroll") for (int nt = 0; nt < 2; ++nt) {                                                            \
      float va; { const float v = accv[mt][nt][i0]; const float rs = rs0; (void)rs; va = (OP); }                   \
      float vb; { const float v = accv[mt][nt][i0 + 1]; const float rs = rs1; (void)rs; vb = (OP); }               \
      const float snd = (r & 1) ? va : vb;                                                                        \
      const float rcv = __shfl_xor(snd, 1);                                                                       \
      const unsigned pk_ = (r & 1) ? pk2(rcv, vb) : pk2(va, rcv);                                                  \
      const unsigned off_ = (unsigned)(m0 + rl0 + (r & 1)) * (unsigned)(LD) + (unsigned)((COLOFF) + n0 + wn * 64 + nt * 32 + (r & ~1)); \
      *(unsigned*)((BASE) + off_) = pk_;                                                                          \
    }                                                                                                             \
  }

DI void phase_in(const Params& p, int L, char* smem) {
  GEMM_IDS
  const int NT = NINP / 128;
  for (int id = blockIdx.x; id < 64 * NT; id += gridDim.x) {
    int tm, tn; map_tile(id, NT, tm, tn);
    const int m0 = tm * 256, n0 = tn * 128;
    f32x16 acc[4][2]; ZERO_ACCM(acc, 4)
    gemm_core<true, false, 4>(p.xb2, D, p.wt_in, D, D, m0, n0, acc, smem);
    const int cb = (n0 >> 6) + wn;
    const int b = m0 >> 11;
    const int sb = (m0 & (S - 1)) + wm * 128;
#pragma unroll
    for (int mt = 0; mt < 4; ++mt)
#pragma unroll
      for (int i = 0; i < 16; ++i) {
        const float rs = rstd_s[wm * 128 + mt * 32 + (i & 3) + 8 * (i >> 2) + 4 * hh];
        acc[mt][0][i] *= rs; acc[mt][1][i] *= rs;
      }
    int grp_;
    if (cb >= 43) grp_ = 16;
    else if (cb < 8) grp_ = 1;
    else if ((cb >= 20 && cb < 24) || cb == 26 || cb == 28 || (cb >= 30 && cb < 38)) grp_ = 2;
    else if ((cb >= 8 && cb < 12) || cb == 27 || cb == 29 || (cb >= 38 && cb < 42)) grp_ = 4;
    else grp_ = 8;
    const bool fused_ = (grp_ == 16) || ((FUSE_MASK & grp_) != 0);
    if (!fused_) {
      EPI_BEGINM(acc, 4)
        const int oc = in_colmap(col);
        if (oc >= 0 && oc < PJN) {
          p.proj[(size_t)row * PJ + oc] = f2bf(v);
          if (oc >= 1952 && oc < 1964) p.small_[row * 16 + (oc - 1952)] = v;
          if (oc >= 2732) p.small_[row * 16 + 12 + (oc - 2732)] = v;
          if (oc >= 1568 && oc < 1632) p.kcmp[(size_t)row * 64 + (oc - 1568)] = f2bf(v);
          if (oc >= 1632 && oc < 1696) p.vcmp[(size_t)row * 64 + (oc - 1632)] = f2bf(v);
        }
      EPI_END
    } else
    if (cb >= 43) {
      if (cb < 107) {
        EPI_BEGINM(acc, 4) p.gates[(size_t)row * 4096 + (col - 2752)] = f2bf(sigmoidf_(v)); EPI_END
      }
    } else if (cb < 8 || (cb >= 20 && cb < 24) || cb == 26 || cb == 28 || (cb >= 30 && cb < 38)) {
      const float* g = nullptr; float sc = 1.f; bfu* dst;
      if (cb < 4)       { sc = 0.125f; dst = p.q_sb + ((size_t)(b * 4 + cb) * S) * 64; }
      else if (cb < 8)  { dst = p.k_sb + ((size_t)(b * 4 + cb - 4) * S) * 64; }
      else if (cb < 24) { g = p.nsa_qn_g + L * 64; sc = 0.125f; dst = p.q_nsa + ((size_t)(b * 4 + cb - 20) * S) * 64; }
      else if (cb == 26) { g = p.nsa_kn_g + (L * 3 + 1) * 64; dst = p.ks + ((size_t)b * S) * 64; }
      else if (cb == 28) { g = p.nsa_kn_g + (L * 3 + 2) * 64; dst = p.kw + ((size_t)b * S) * 64; }
      else if (cb < 34) { g = p.fox_qn_g + L * 64; sc = 0.125f; dst = p.q_fox + ((size_t)(b * 4 + cb - 30) * S) * 64; }
      else              { g = p.fox_kn_g + L * 64; dst = p.k_fox + ((size_t)(b * 4 + cb - 34) * S) * 64; }
      float g0 = sc, g1 = sc;
      if (g) { g0 = g[r] * sc; g1 = g[32 + r] * sc; }
#pragma unroll
      for (int mt = 0; mt < 4; ++mt)
#pragma unroll
        for (int i = 0; i < 16; ++i) {
          float v0 = acc[mt][0][i], v1 = acc[mt][1][i];
          float rs = 1.f;
          if (g) {
            float ss = v0 * v0 + v1 * v1;
            ss += __shfl_xor(ss, 1); ss += __shfl_xor(ss, 2); ss += __shfl_xor(ss, 4); ss += __shfl_xor(ss, 8); ss += __shfl_xor(ss, 16);
            rs = rsqrtf(ss * (1.f / 64.f) + EPS);
          }
          const int sq = sb + mt * 32 + (i & 3) + 8 * (i >> 2) + 4 * hh;
          dst[(size_t)sq * 64 + r] = f2bf(v0 * rs * g0);
          dst[(size_t)sq * 64 + 32 + r] = f2bf(v1 * rs * g1);
        }
    } else if ((cb >= 8 && cb < 12) || cb == 27 || cb == 29 || cb >= 38) {
      if (cb < 42) {
        bfu* dst;
        if (cb < 12) dst = p.vt_sb + ((size_t)(b * 4 + cb - 8) * 64) * S;
        else if (cb == 27) dst = p.vts + ((size_t)b * 64) * S;
        else if (cb == 29) dst = p.vtw + ((size_t)b * 64) * S;
        else dst = p.vt_fox + ((size_t)(b * 4 + cb - 38) * 64) * S;
#pragma unroll
        for (int mt = 0; mt < 4; ++mt)
#pragma unroll
          for (int nt = 0; nt < 2; ++nt)
#pragma unroll
            for (int g4 = 0; g4 < 4; ++g4) {
              const int sq = sb + mt * 32 + 8 * g4 + 4 * hh;
              u32x2 v = {pk2(acc[mt][nt][4 * g4], acc[mt][nt][4 * g4 + 1]), pk2(acc[mt][nt][4 * g4 + 2], acc[mt][nt][4 * g4 + 3])};
              *(u32x2*)(dst + (size_t)(nt * 32 + r) * S + sq) = v;
            }
      } else {
#pragma unroll
        for (int mt = 0; mt < 4; ++mt)
#pragma unroll
          for (int i = 0; i < 16; ++i) {
            const size_t row = (size_t)m0 + wm * 128 + mt * 32 + (i & 3) + 8 * (i >> 2) + 4 * hh;
            p.krope[row * 32 + r] = f2bf(acc[mt][0][i]);
            if (r < 16) p.small_[row * 16 + r] = acc[mt][1][i];
          }
      }
    } else {
      bfu* dst; int ld, c0;
      if (cb < 18) { dst = p.cq; ld = 384; c0 = (cb - 12) * 64; }
      else if (cb < 20) { dst = p.ckv; ld = 128; c0 = (cb - 18) * 64; }
      else if (cb == 24) { dst = p.kcmp; ld = 64; c0 = 0; }
      else { dst = p.vcmp; ld = 64; c0 = 0; }
#pragma unroll
      for (int mt = 0; mt < 4; ++mt)
#pragma unroll
        for (int i = 0; i < 16; ++i) {
          const size_t row = (size_t)m0 + wm * 128 + mt * 32 + (i & 3) + 8 * (i >> 2) + 4 * hh;
          dst[row * ld + c0 + r] = f2bf(acc[mt][0][i]);
          dst[row * ld + c0 + 32 + r] = f2bf(acc[mt][1][i]);
        }
    }
  }
}

constexpr int TP = 66;
DI void tr_load(const bfu* __restrict__ src, int pitch, bfu* T) {
  const int tid = TID();
#pragma unroll
  for (int j = 0; j < 4; ++j) {
    int c = tid + 256 * j; int tok = c >> 4, q = c & 15;
    u32x2 v = *(const u32x2*)(src + (size_t)tok * pitch + q * 4);
    *(unsigned*)(T + tok * TP + q * 4) = v[0];
    *(unsigned*)(T + tok * TP + q * 4 + 2) = v[1];
  }
}
DI void tr_store(const bfu* T, bfu* __restrict__ dst  ) {
  const int tid = TID();
#pragma unroll
  for (int j = 0; j < 2; ++j) {
    int c = tid + 256 * j; int d = c & 63, tc = c >> 6;
    bfu e[8];
#pragma unroll
    for (int q = 0; q < 8; ++q) e[q] = T[(tc * 8 + q) * TP + d];
    u32x4 o = {(unsigned)e[0] | ((unsigned)e[1] << 16), (unsigned)e[2] | ((unsigned)e[3] << 16), (unsigned)e[4] | ((unsigned)e[5] << 16), (unsigned)e[6] | ((unsigned)e[7] << 16)};
    *(u32x4*)(dst + (size_t)d * S + tc * 8) = o;
  }
}

DI void prep_item(const Params& p, int L, int item, char* smem) {
  const int tid = TID();
  const int b = item >> 5, s0 = (item & 31) * 64;
  const size_t t0 = (size_t)b * S + s0;
  const int sub = tid & 7;
#pragma unroll 1
  for (int jb = 0; jb < 44; jb += 4) {
    u32x2 v0[4], v1[4];
#pragma unroll
    for (int u = 0; u < 4; ++u) {
      const int job = (tid >> 3) + 32 * (jb + u);
      const int tok = job & 63, vec = job >> 6;
      int col;
      if (vec < 4) col = 64 * vec; else if (vec < 8) col = 256 + 64 * (vec - 4); else if (vec < 12) col = 1964 + 64 * (vec - 8);
      else if (vec < 16) col = 2220 + 64 * (vec - 12); else if (vec < 20) col = 1312 + 64 * (vec - 16); else if (vec == 20) col = 1696; else col = 1824;
      const bfu* src = p.proj + (t0 + tok) * PJ + col + sub * 8;
      v0[u] = *(const u32x2*)src; v1[u] = *(const u32x2*)(src + 4);
    }
#pragma unroll
    for (int u = 0; u < 4; ++u) {
      const int job = (tid >> 3) + 32 * (jb + u);
      const int tok = job & 63, vec = job >> 6;
      if ((vec < 8) ? (FUSE_MASK & 1) : (FUSE_MASK & 2)) continue;
      const float* g = nullptr; float sc = 1.f; bfu* dst;
      if (vec < 4)       { sc = 0.125f; dst = p.q_sb + (((size_t)(b * 4 + vec)) * S + s0 + tok) * 64; }
      else if (vec < 8)  { int h = vec - 4; dst = p.k_sb + (((size_t)(b * 4 + h)) * S + s0 + tok) * 64; }
      else if (vec < 12) { int h = vec - 8; g = p.fox_qn_g + L * 64; sc = 0.125f; dst = p.q_fox + (((size_t)(b * 4 + h)) * S + s0 + tok) * 64; }
      else if (vec < 16) { int h = vec - 12; g = p.fox_kn_g + L * 64; dst = p.k_fox + (((size_t)(b * 4 + h)) * S + s0 + tok) * 64; }
      else if (vec < 20) { int h = vec - 16; g = p.nsa_qn_g + L * 64; sc = 0.125f; dst = p.q_nsa + (((size_t)(b * 4 + h)) * S + s0 + tok) * 64; }
      else if (vec == 20) { g = p.nsa_kn_g + (L * 3 + 1) * 64; dst = p.ks + ((size_t)b * S + s0 + tok) * 64; }
      else               { g = p.nsa_kn_g + (L * 3 + 2) * 64; dst = p.kw + ((size_t)b * S + s0 + tok) * 64; }
      float e[8] = {bflo(v0[u][0]), bfhi(v0[u][0]), bflo(v0[u][1]), bfhi(v0[u][1]), bflo(v1[u][0]), bfhi(v1[u][0]), bflo(v1[u][1]), bfhi(v1[u][1])};
      float ss = 0.f;
#pragma unroll
      for (int q = 0; q < 8; ++q) ss += e[q] * e[q];
      ss += __shfl_xor(ss, 1); ss += __shfl_xor(ss, 2); ss += __shfl_xor(ss, 4);
      const float rs = g ? rsqrtf(ss * (1.f / 64.f) + EPS) * sc : sc;
#pragma unroll
      for (int q = 0; q < 8; ++q) e[q] = e[q] * rs * (g ? g[sub * 8 + q] : 1.f);
      *(u32x4*)(dst + sub * 8) = (u32x4){pk2(e[0], e[1]), pk2(e[2], e[3]), pk2(e[4], e[5]), pk2(e[6], e[7])};
    }
  }
  if (!(FUSE_MASK & 8)) {
    const int tok = tid >> 2, sub = tid & 3;
    *(u32x4*)(p.krope + (t0 + tok) * 32 + sub * 8) = *(const u32x4*)(p.proj + (t0 + tok) * PJ + 1280 + sub * 8);
  }
  bfu* T = (bfu*)smem;
  if (!(FUSE_MASK & 4))
  for (int grp = 0; grp < 2; ++grp) {
    __syncthreads();
#pragma unroll 1
    for (int q = 0; q < 5; ++q) {
      int v = grp * 5 + q; int col;
      if (v < 4) col = 512 + 64 * v; else if (v < 8) col = 2476 + 64 * (v - 4); else if (v == 8) col = 1760; else col = 1888;
      tr_load(p.proj + t0 * PJ + col, PJ, T + q * 64 * TP);
    }
    __syncthreads();
#pragma unroll 1
    for (int q = 0; q < 5; ++q) {
      int v = grp * 5 + q; bfu* dst;
      if (v < 4) dst = p.vt_sb + ((size_t)(b * 4 + v) * 64) * S + s0;
      else if (v < 8) dst = p.vt_fox + ((size_t)(b * 4 + (v - 4)) * 64) * S + s0;
      else if (v == 8) dst = p.vts + ((size_t)b * 64) * S + s0;
      else dst = p.vtw + ((size_t)b * 64) * S + s0;
      tr_store(T + q * 64 * TP, dst);
    }
  }
}

DI void compress_item(const Params& p, int L, int item, char* smem) {
  GEMM_IDS
  const int b = item >> 1, kv = item & 1;
  const int m0 = 0, n0 = 0;
  f32x16 acc[2][2]; ZERO_ACC(acc)
  gemm_core<false>((kv ? p.vcmp : p.kcmp) + (size_t)b * S * 64, 1024, p.wt_w1 + (size_t)kv * 128 * 2048, 2048, 2048, 0, 0, acc, smem);
  float* Hs = (float*)smem;
  float* W2 = (float*)(smem + 128 * 65 * 4);
  const float* w2 = (kv ? p.nsa_w2_v : p.nsa_w2_k) + (size_t)L * 64 * 64;
  for (int e = tid; e < 1024; e += 256) *(float4*)(W2 + e * 4) = *(const float4*)(w2 + e * 4);
  if (wn == 0) {
#pragma unroll
    for (int mt = 0; mt < 2; ++mt)
#pragma unroll
      for (int nt = 0; nt < 2; ++nt)
#pragma unroll
        for (int i = 0; i < 16; ++i) {
          const int rl = wm * 64 + mt * 32 + (i & 3) + 8 * (i >> 2) + 4 * hh;
          const int n = nt * 32 + r;
          float pb_ = 0.f;
#pragma unroll
          for (int q8 = 0; q8 < 8; ++q8) pb_ += p.pebias[(kv * 8 + q8) * 64 + n];
          const float hsum = acc[mt][nt][i] + pb_;
          Hs[rl * 65 + n] = hsum / (1.f + __expf(-hsum));
        }
  }
  (void)m0; (void)n0;
  __syncthreads();
  const int row = tid >> 1, nh = tid & 1;
  float o[32];
#pragma unroll
  for (int j = 0; j < 32; ++j) o[j] = 0.f;
  for (int k = 0; k < 64; ++k) {
    const float hk = Hs[row * 65 + k];
    const float* wr = W2 + k * 64 + nh * 32;
#pragma unroll
    for (int j = 0; j < 32; j += 4) { float4 w4 = *(const float4*)(wr + j); o[j] += hk * w4.x; o[j + 1] += hk * w4.y; o[j + 2] += hk * w4.z; o[j + 3] += hk * w4.w; }
  }
  if (kv == 0) {
    float ss = 0.f;
#pragma unroll
    for (int j = 0; j < 32; ++j) ss += o[j] * o[j];
    ss += __shfl_xor(ss, 1);
    const float rs = rsqrtf(ss * (1.f / 64.f) + EPS);
    const float* g = p.nsa_kn_g + (L * 3 + 0) * 64 + nh * 32;
#pragma unroll
    for (int j = 0; j < 32; ++j) o[j] = o[j] * rs * g[j];
  }
  if (row == 127) {
#pragma unroll
    for (int j = 0; j < 32; ++j) o[j] = 0.f;
  }
  if (kv == 0) {
    bfu* dst = p.kc_b + ((size_t)b * 128 + row) * 64 + nh * 32;
#pragma unroll
    for (int j = 0; j < 32; j += 8) *(u32x4*)(dst + j) = (u32x4){pk2(o[j], o[j + 1]), pk2(o[j + 2], o[j + 3]), pk2(o[j + 4], o[j + 5]), pk2(o[j + 6], o[j + 7])};
  } else {
    bfu* dst = p.vct_b + ((size_t)b * 64 + nh * 32) * 128 + row;
#pragma unroll
    for (int j = 0; j < 32; ++j) dst[(size_t)j * 128] = f2bf(o[j]);
  }
  __syncthreads();
}

DI void foxcum_item(const Params& p, int L, int item) {
  const int tid = TID(), lane = tid & 63, w = tid >> 6;
  const int job = item * 4 + w;
  const int b = job >> 2, h = job & 3;
  const float fb = p.fox_f_bias[L * 4 + h];
  float v[32]; float run = 0.f;
#pragma unroll
  for (int q = 0; q < 32; ++q) {
    float z = p.small_[((size_t)b * S + lane * 32 + q) * 16 + 12 + h] + fb;
    float ls = fminf(z, 0.f) - __logf(1.f + __expf(-fabsf(z)));
    run += ls; v[q] = run;
  }
  float inc = run;
#pragma unroll
  for (int q = 1; q < 64; q <<= 1) { float t = __shfl_up(inc, q); if (lane >= q) inc += t; }
  float excl = inc - run;
#pragma unroll
  for (int q = 0; q < 32; ++q) p.cum[((size_t)(b * 4 + h)) * S + lane * 32 + q] = v[q] + excl;
}

DI void phase_prep(const Params& p, int L, char* smem) {
  GEMM_IDS
  const int N_CMP = 16, N_PREP = (FUSE_MASK & 15) == 15 ? 0 : 256, N_G2 = 128 * 3, N_G3 = 128 * 4, N_FC = 8;
  const int o1 = N_CMP, o2 = o1 + N_FC, o3 = o2 + N_PREP, o4 = o3 + N_G2, o5 = o4 + N_G3;
  for (int it = blockIdx.x; it < o5; it += gridDim.x) {
    if (it < o1) compress_item(p, L, it, smem);
    else if (it < o2) foxcum_item(p, L, it - o1);
    else if (it < o3) prep_item(p, L, it - o2, smem);
    else if (it < o4) {
      const int t = it - o3; const int m0 = (t / 3) * 128, n0 = (t % 3) * 128;
      f32x16 acc[2][2]; ZERO_ACC(acc)
      if (FUSE_MASK & 8) gemm_core<true>(p.cq, 384, p.wt_uq, 384, 384, m0, n0, acc, smem);
      else gemm_core<true>(p.proj + 768, PJ, p.wt_uq, 384, 384, m0, n0, acc, smem);
      EPI_BEGIN(acc) p.qraw[(size_t)row * 384 + col] = f2bf(v * rstd_s[rl]); EPI_END
    } else {
      const int t = it - o4; const int m0 = (t >> 2) * 128, n0 = (t & 3) * 128;
      f32x16 acc[2][2]; ZERO_ACC(acc)
      if (FUSE_MASK & 8) gemm_core<true>(p.ckv, 128, p.wt_ukv, 128, 128, m0, n0, acc, smem);
      else gemm_core<true>(p.proj + 1152, PJ, p.wt_ukv, 128, 128, m0, n0, acc, smem);
      EPI_BEGIN(acc) p.kvraw[(size_t)row * 512 + col] = f2bf(v * rstd_s[rl]); EPI_END
    }
  }
}

DI void mlaprep_item(const Params& p, int L, int item, char* smem) {
  const int tid = TID();
  const int b = item >> 5, s0 = (item & 31) * 64;
  const int tok = tid >> 2, h = tid & 3;
  const int spos = s0 + tok;
  const size_t t = (size_t)b * S + spos;
#pragma unroll 1
  for (int which = 0; which < 2; ++which) {
    const bfu* srcA = which ? (p.kvraw + t * 512 + h * 128) : (p.qraw + t * 384 + h * 96);
    const bfu* srcB = which ? (p.krope + t * 32) : (p.qraw + t * 384 + h * 96 + 64);
    const float* g = (which ? p.mla_kn_g : p.mla_qn_g) + L * 96;
    float ss = 0.f;
#pragma unroll
    for (int c = 0; c < 12; ++c) {
      u32x4 v = *(const u32x4*)((c < 8) ? (srcA + c * 8) : (srcB + (c - 8) * 8));
#pragma unroll
      for (int q = 0; q < 4; ++q) { float lo = bflo(v[q]), hi = bfhi(v[q]); ss += lo * lo + hi * hi; }
    }
    const float sc = which ? 1.f : 0.10206207261596577f;
    const float rs = rsqrtf(ss * (1.f / 96.f) + EPS) * sc;
    bfu* dst = (which ? p.k_mla : p.q_mla) + (((size_t)(b * 4 + h)) * S + spos) * 96;
#pragma unroll
    for (int c = 0; c < 8; ++c) {
      u32x4 v = *(const u32x4*)(srcA + c * 8);
      const float* gc = g + c * 8;
      *(u32x4*)(dst + c * 8) = (u32x4){pk2(bflo(v[0]) * rs * gc[0], bfhi(v[0]) * rs * gc[1]), pk2(bflo(v[1]) * rs * gc[2], bfhi(v[1]) * rs * gc[3]),
                                       pk2(bflo(v[2]) * rs * gc[4], bfhi(v[2]) * rs * gc[5]), pk2(bflo(v[3]) * rs * gc[6], bfhi(v[3]) * rs * gc[7])};
    }
#pragma unroll
    for (int c = 0; c < 2; ++c) {
      u32x4 va = *(const u32x4*)(srcB + c * 8);
      u32x4 vb = *(const u32x4*)(srcB + 16 + c * 8);
      float oa[8], ob[8];
#pragma unroll
      for (int q = 0; q < 8; ++q) {
        const int i2 = c * 8 + q;
        float a = ((q & 1) ? bfhi(va[q >> 1]) : bflo(va[q >> 1])) * rs * g[64 + i2];
        float bb = ((q & 1) ? bfhi(vb[q >> 1]) : bflo(vb[q >> 1])) * rs * g[80 + i2];
        float inv = expf(-9.210340371976184f * (float)i2 / 16.f);
        float ang = (float)spos * inv;
        double rv = (double)ang * 0.15915494309189535; rv -= floor(rv);
        float fr = (float)rv;
        float cs = __builtin_amdgcn_cosf(fr), sn = __builtin_amdgcn_sinf(fr);
        oa[q] = a * cs - bb * sn; ob[q] = bb * cs + a * sn;
      }
      *(u32x4*)(dst + 64 + c * 8) = (u32x4){pk2(oa[0], oa[1]), pk2(oa[2], oa[3]), pk2(oa[4], oa[5]), pk2(oa[6], oa[7])};
      *(u32x4*)(dst + 80 + c * 8) = (u32x4){pk2(ob[0], ob[1]), pk2(ob[2], ob[3]), pk2(ob[4], ob[5]), pk2(ob[6], ob[7])};
    }
  }
  bfu* T = (bfu*)smem;
  __syncthreads();
#pragma unroll 1
  for (int q = 0; q < 4; ++q) tr_load(p.kvraw + ((size_t)b * S + s0) * 512 + q * 128 + 64, 512, T + q * 64 * TP);
  __syncthreads();
#pragma unroll 1
  for (int q = 0; q < 4; ++q) tr_store(T + q * 64 * TP, p.vt_mla + ((size_t)(b * 4 + q) * 64) * S + s0);
}

DI int rel_bucket_dev(int d) {
  if (d < 16) return d;
  int v = 16 + (int)(logf((float)d / 16.f) / 2.0794415416798357f * 16.f);
  return v < 31 ? v : 31;
}

DI void nsacmp_item(const Params& p, int L, int item, char* smem) {
  (void)L;
  const int tid = TID(), lane = tid & 63, w = __builtin_amdgcn_readfirstlane(tid >> 6), r = lane & 31, hh = lane >> 5;
  const int b = item >> 6, s0 = (item & 63) * 32;
  constexpr int CKP = 72, CVP = 136;
  bfu* Ks = (bfu*)smem;
  bfu* Vt = (bfu*)(smem + 18432);
  float* lut = (float*)(smem + 35840);
  float* impx = (float*)(smem + 37952);
  const int tmax = s0 + 31;
  const int ncv_max = tmax >= 31 ? (tmax - 31) / 16 + 1 : 0;
  const int nct = (ncv_max + 31) >> 5;
  __syncthreads();
#pragma unroll
  for (int j = 0; j < 4; ++j) {
    const int c = tid + 256 * j;
    const int row = c >> 3, kc8 = c & 7;
    *(u32x4*)(Ks + row * CKP + kc8 * 8) = *(const u32x4*)(p.kc_b + ((size_t)b * 128 + row) * 64 + kc8 * 8);
    const int d = c >> 4, cc = c & 15;
    *(u32x4*)(Vt + d * CVP + cc * 8) = *(const u32x4*)(p.vct_b + ((size_t)b * 64 + d) * 128 + cc * 8);
  }
  for (int e = tid; e < 4 * 129; e += 256) { int hq = e / 129, d = e % 129; lut[hq * 132 + d] = p.rel_bias[rel_bucket_dev(d) * 4 + hq]; }
  __syncthreads();
  const int h = w;
  const int spos = s0 + r;
  const size_t t = (size_t)b * S + spos;
  bf16x8 qf[4];
#pragma unroll
  for (int ks = 0; ks < 4; ++ks) qf[ks] = *(const bf16x8*)(p.q_nsa + (((size_t)(b * 4 + h)) * S + spos) * 64 + ks * 16 + hh * 8);
  f32x16 sc[4];
#pragma unroll
  for (int ct = 0; ct < 4; ++ct) {
#pragma unroll
    for (int i = 0; i < 16; ++i) sc[ct][i] = 0.f;
    if (ct < nct) {
#pragma unroll
      for (int ks = 0; ks < 4; ++ks) {
        bf16x8 a = *(const bf16x8*)(Ks + (32 * ct + r) * CKP + ks * 16 + hh * 8);
        sc[ct] = MFMA(a, qf[ks], sc[ct]);
      }
    }
  }
  const int ncv = spos >= 31 ? (spos - 31) / 16 + 1 : 0;
  const float* lutl = lut + h * 132;
  float mx = -INFINITY;
#pragma unroll
  for (int ct = 0; ct < 4; ++ct)
#pragma unroll
    for (int i = 0; i < 16; ++i) {
      const int c = 32 * ct + (i & 3) + 8 * (i >> 2) + 4 * hh;
      int dd = spos - 16 * c - 31; dd = dd < 0 ? 0 : (dd > 128 ? 128 : dd);
      const float sv = (c < ncv) ? (sc[ct][i] + lutl[dd]) : -INFINITY;
      sc[ct][i] = sv; mx = fmaxf(mx, sv);
    }
  mx = fmaxf(mx, __shfl_xor(mx, 32));
  const float m_use = (mx == -INFINITY) ? 0.f : mx;
  float l = 0.f;
#pragma unroll
  for (int ct = 0; ct < 4; ++ct)
#pragma unroll
    for (int i = 0; i < 16; ++i) { const float pv = __expf(sc[ct][i] - m_use); sc[ct][i] = pv; l += pv; }
  l += __shfl_xor(l, 32);
  const float il = (l > 0.f) ? 1.f / l : 0.f;
#pragma unroll
  for (int ct = 0; ct < 4; ++ct)
#pragma unroll
    for (int i = 0; i < 16; ++i) sc[ct][i] *= il;
  {
    float* imr = impx + (h * 32 + r) * 33;
    float prev = 0.f;
#pragma unroll
    for (int ct = 0; ct < 4; ++ct)
#pragma unroll
      for (int g = 0; g < 4; ++g) {
        const float G = (sc[ct][4 * g] + sc[ct][4 * g + 1]) + (sc[ct][4 * g + 2] + sc[ct][4 * g + 3]);
        const float rcv = __shfl_xor(sc[ct][4 * g + 3], 32);
        const float extra = hh ? rcv : prev;
        imr[8 * ct + 2 * g + hh] = G + extra;
        prev = rcv;
      }
  }
  f32x16 o[2];
#pragma unroll
  for (int dt = 0; dt < 2; ++dt)
#pragma unroll
    for (int i = 0; i < 16; ++i) o[dt][i] = 0.f;
#pragma unroll
  for (int ct = 0; ct < 4; ++ct) {
    if (ct < nct) {
#pragma unroll
      for (int s2 = 0; s2 < 2; ++s2) {
        bf16x8 pf = PACK8(sc[ct], 8 * s2);
#pragma unroll
        for (int dt = 0; dt < 2; ++dt) {
          const bfu* vp = Vt + (32 * dt + r) * CVP + 32 * ct + 16 * s2 + 4 * hh;
          s16x4 lo4 = *(const s16x4*)vp;
          s16x4 hi4 = *(const s16x4*)(vp + 8);
          bf16x8 a = __builtin_shufflevector(lo4, hi4, 0, 1, 2, 3, 4, 5, 6, 7);
          o[dt] = MFMA(a, pf, o[dt]);
        }
      }
    }
  }
  {
    const float g0 = sigmoidf_(p.small_[t * 16 + 0 * 4 + h]);
    float* dst = p.ocmp + (t * 4 + h) * 64;
#pragma unroll
    for (int dt = 0; dt < 2; ++dt)
#pragma unroll
      for (int g = 0; g < 4; ++g)
        *(float4*)(dst + 32 * dt + 8 * g + 4 * hh) = make_float4(o[dt][4 * g] * g0, o[dt][4 * g + 1] * g0, o[dt][4 * g + 2] * g0, o[dt][4 * g + 3] * g0);
  }
  __syncthreads();
  {
    const int tk = tid >> 3, sub = tid & 7;
    float* i0 = impx + tk * 33;
#pragma unroll
    for (int q = 0; q < 4; ++q) {
      const int j = sub * 4 + q;
      i0[j] = (i0[j] + impx[(32 + tk) * 33 + j]) + (impx[(64 + tk) * 33 + j] + impx[(96 + tk) * 33 + j]);
    }
    __syncthreads();
    const int sp = s0 + tk;
    const int cur = sp >> 6;
    unsigned mask = 0;
#pragma unroll 1
    for (int q = 0; q < 4; ++q) {
      const int j = sub * 4 + q;
      if (j <= cur) {
        const bool fj = (j == 0) || (j == cur) || (j == cur - 1);
        const float vj = fj ? 1e9f : i0[j];
        int rank = 0;
        for (int i2 = 0; i2 <= cur; ++i2) {
          const bool fi = (i2 == 0) || (i2 == cur) || (i2 == cur - 1);
          const float vi = fi ? 1e9f : i0[i2];
          rank += (vi > vj || (vi == vj && i2 < j)) ? 1 : 0;
        }
        if (rank < 16) mask |= (1u << j);
      }
    }
    mask |= __shfl_xor(mask, 1); mask |= __shfl_xor(mask, 2); mask |= __shfl_xor(mask, 4);
    if (sub == 0) p.selmask[(size_t)b * S + sp] = mask;
  }
}

constexpr int VP = 72;
constexpr int AT_KS = 0, AT_VS = 13312, AT_CUM = 22528, AT_FLAGS = 22784, AT_OR = 22800, AT_LUT = 22816;

template <int MODE>
DI void attn_run(const bfu* __restrict__ Qp, const bfu* __restrict__ Kp, const bfu* __restrict__ Vtp, int qt,
                 f32x16 (&o)[2], const float* __restrict__ cump, unsigned sel, unsigned blockmask, char* smem) {
  constexpr int DK = (MODE == 1) ? 96 : 64;
  constexpr int KP = DK + 8;
  constexpr int NKS = DK / 16;
  constexpr int KCH = DK / 8;
  constexpr int NKC = 64 * KCH / 256;
  bfu* Ks = (bfu*)(smem + AT_KS);
  bfu* Vs = (bfu*)(smem + AT_VS);
  float* cumk = (float*)(smem + AT_CUM);
  int* flags = (int*)(smem + AT_FLAGS);
  const float* lut = (const float*)(smem + AT_LUT);
  const int tid = TID(), lane = tid & 63, w = tid >> 6, r = lane & 31, hh = lane >> 5;
  const int q0 = qt * 128;
  const int t = q0 + w * 32 + r;
  const int tw_min = q0 + w * 32, tw_max = tw_min + 31;
  bf16x8 qf[NKS];
#pragma unroll
  for (int ks = 0; ks < NKS; ++ks) qf[ks] = *(const bf16x8*)(Qp + (size_t)t * DK + ks * 16 + hh * 8);
  float cumq = 0.f;
  if (MODE == 2) cumq = cump[t];
  bf16x8 U[2];
  if (MODE == 0) {
#pragma unroll
    for (int s2 = 0; s2 < 2; ++s2)
#pragma unroll
      for (int j = 0; j < 8; ++j) { int kk = 16 * s2 + 8 * (j >> 2) + 4 * hh + (j & 3); U[s2][j] = (kk > r) ? (short)0x3F80 : (short)0; }
  }
#pragma unroll
  for (int dt = 0; dt < 2; ++dt)
#pragma unroll
    for (int i = 0; i < 16; ++i) o[dt][i] = 0.f;
  float m = -INFINITY, l = 0.f, carry = 0.f;

  int kt_lo = 0, kt_hi = 2 * qt + 1;
  if (MODE == 4) kt_lo = (2 * qt - 8) > 0 ? (2 * qt - 8) : 0;
  int kt;
  if (MODE == 0) kt = kt_hi;
  else if (MODE == 3) { kt = kt_lo; while (kt <= kt_hi && !((blockmask >> kt) & 1u)) ++kt; }
  else kt = kt_lo;
  u32x4 rk[NKC], rv[2]; float rc = 0.f;
#define ATT_LOAD(KT)                                                                                              \
  { const int k0_ = (KT) * 64;                                                                                    \
    _Pragma("unroll") for (int j = 0; j < NKC; ++j) { int c = tid + 256 * j; int row = c / KCH, kc = c % KCH;       \
      rk[j] = *(const u32x4*)(Kp + (size_t)(k0_ + row) * DK + kc * 8); }                                           \
    _Pragma("unroll") for (int j = 0; j < 2; ++j) { int c = tid + 256 * j; int d = c >> 3, kc = c & 7;              \
      rv[j] = *(const u32x4*)(Vtp + (size_t)d * S + k0_ + kc * 8); }                                               \
    if (MODE == 2) { if (tid < 64) rc = cump[k0_ + tid]; } }
  if (kt <= kt_hi && kt >= 0) { ATT_LOAD(kt) }
  while (kt >= kt_lo && kt <= kt_hi) {
    BAR_LDS();
    if (MODE == 0) { if (flags[0] && flags[1] && flags[2] && flags[3]) break; }
#pragma unroll
    for (int j = 0; j < NKC; ++j) { int c = tid + 256 * j; int row = c / KCH, kc = c % KCH; *(u32x4*)(Ks + row * KP + kc * 8) = rk[j]; }
#pragma unroll
    for (int j = 0; j < 2; ++j) { int c = tid + 256 * j; int d = c >> 3, kc = c & 7; *(u32x4*)(Vs + d * VP + kc * 8) = rv[j]; }
    if (MODE == 2) { if (tid < 64) cumk[tid] = rc; }
    BAR_LDS();
    int nkt;
    if (MODE == 0) nkt = kt - 1;
    else if (MODE == 3) { nkt = kt + 1; while (nkt <= kt_hi && !((blockmask >> nkt) & 1u)) ++nkt; }
    else nkt = kt + 1;
    { const int lk_ = (nkt >= kt_lo && nkt <= kt_hi) ? nkt : kt;
      ATT_LOAD(lk_) }
    const int k0 = kt * 64;
    bool active;
    if (MODE == 0) active = (k0 < tw_max);
    else if (MODE == 4) active = (k0 <= tw_max) && (k0 + 63 >= tw_min - 511);
    else active = (k0 <= tw_max);
    if (active) {
      f32x16 sc[2];
#pragma unroll
      for (int mt = 0; mt < 2; ++mt) {
#pragma unroll
        for (int i = 0; i < 16; ++i) sc[mt][i] = 0.f;
#pragma unroll
        for (int ks = 0; ks < NKS; ++ks) {
          bf16x8 a = *(const bf16x8*)(Ks + (32 * mt + r) * KP + ks * 16 + hh * 8);
          sc[mt] = MFMA(a, qf[ks], sc[mt]);
        }
      }
      if (MODE == 0) {
        f32x16 Lm[2]; float cs[2];
#pragma unroll
        for (int mt = 0; mt < 2; ++mt) {
          float c_ = 0.f;
#pragma unroll
          for (int i = 0; i < 16; ++i) {
            const int key = k0 + 32 * mt + (i & 3) + 8 * (i >> 2) + 4 * hh;
            const float z = sc[mt][i];
            const bool past = key < t;
            const float sp = fmaxf(z, 0.f) + __logf(1.f + __expf(-fabsf(z)));
            const float Lv = past ? -sp : 0.f;
            Lm[mt][i] = Lv; c_ += Lv;
            sc[mt][i] = past ? (z - sp) : -INFINITY;
          }
          c_ += __shfl_xor(c_, 32);
          cs[mt] = c_;
        }
#pragma unroll
        for (int mt = 0; mt < 2; ++mt) {
          f32x16 bt;
#pragma unroll
          for (int i = 0; i < 16; ++i) bt[i] = 0.f;
#pragma unroll
          for (int s2 = 0; s2 < 2; ++s2) {
            float lo8[8]; unsigned hb[8];
#pragma unroll
            for (int j = 0; j < 8; ++j) { float Lv = Lm[mt][8 * s2 + j]; bfu hbits = f2bf(Lv); hb[j] = hbits; lo8[j] = Lv - bf2f(hbits); }
            bf16x8 hi = __builtin_bit_cast(bf16x8, (u32x4){hb[0] | (hb[1] << 16), hb[2] | (hb[3] << 16), hb[4] | (hb[5] << 16), hb[6] | (hb[7] << 16)});
            bf16x8 lo = __builtin_bit_cast(bf16x8, (u32x4){pk2(lo8[0], lo8[1]), pk2(lo8[2], lo8[3]), pk2(lo8[4], lo8[5]), pk2(lo8[6], lo8[7])});
            bt = MFMA(U[s2], hi, bt);
            bt = MFMA(U[s2], lo, bt);
          }
          const float add = carry + (mt == 0 ? cs[1] : 0.f);
#pragma unroll
          for (int i = 0; i < 16; ++i) sc[mt][i] = __expf(sc[mt][i] + bt[i] + add);
        }
        carry += cs[0] + cs[1];
      } else {
        float mxv = -INFINITY;
        const bool need_mask = (MODE == 3) || (k0 + 63 > tw_min) || (MODE == 4 && (k0 < tw_max - 511));
        if (need_mask) {
#pragma unroll
          for (int mt = 0; mt < 2; ++mt)
#pragma unroll
            for (int i = 0; i < 16; ++i) {
              const int kl = 32 * mt + (i & 3) + 8 * (i >> 2) + 4 * hh;
              const int key = k0 + kl;
              float s = sc[mt][i];
              bool valid;
              if (MODE == 1) valid = key <= t;
              else if (MODE == 2) { valid = key <= t; s += cumq - cumk[kl]; }
              else {
                int dd = t - key;
                if (MODE == 3) valid = (dd >= 0) && ((sel >> kt) & 1u); else valid = (dd >= 0) && (dd < 512);
                int di = dd < 0 ? 0 : (dd > 128 ? 128 : dd);
                s += lut[di];
              }
              s = valid ? s : -INFINITY;
              sc[mt][i] = s; mxv = fmaxf(mxv, s);
            }
        } else {
#pragma unroll
          for (int mt = 0; mt < 2; ++mt)
#pragma unroll
            for (int i = 0; i < 16; ++i) {
              const int kl = 32 * mt + (i & 3) + 8 * (i >> 2) + 4 * hh;
              float s = sc[mt][i];
              if (MODE == 2) s += cumq - cumk[kl];
              if (MODE == 4) { int dd = t - (k0 + kl); s += lut[dd > 128 ? 128 : dd]; }
              sc[mt][i] = s; mxv = fmaxf(mxv, s);
            }
        }
        mxv = fmaxf(mxv, __shfl_xor(mxv, 32));
        const float m_new = fmaxf(m, mxv);
        const float m_use = (m_new == -INFINITY) ? 0.f : m_new;
        if (__any(m_new != m)) {
          const float alpha = __expf(m - m_use);
          l *= alpha;
#pragma unroll
          for (int dt = 0; dt < 2; ++dt)
#pragma unroll
            for (int i = 0; i < 16; ++i) o[dt][i] *= alpha;
        }
        const float mL = m_use * 1.4426950408889634f;
        float ps = 0.f;
#pragma unroll
        for (int mt = 0; mt < 2; ++mt)
#pragma unroll
          for (int i = 0; i < 16; ++i) { float pv = __builtin_amdgcn_exp2f(__builtin_fmaf(sc[mt][i], 1.4426950408889634f, -mL)); ps += pv; sc[mt][i] = pv; }
        l += ps; m = m_new;
      }
#pragma unroll
      for (int mt = 0; mt < 2; ++mt)
#pragma unroll
        for (int s2 = 0; s2 < 2; ++s2) {
          bf16x8 pf = PACK8(sc[mt], 8 * s2);
#pragma unroll
          for (int dt = 0; dt < 2; ++dt) {
            const bfu* vp = Vs + (32 * dt + r) * VP + 32 * mt + 16 * s2 + 4 * hh;
            s16x4 lo4 = *(const s16x4*)vp;
            s16x4 hi4 = *(const s16x4*)(vp + 8);
            bf16x8 a = __builtin_shufflevector(lo4, hi4, 0, 1, 2, 3, 4, 5, 6, 7);
            o[dt] = MFMA(a, pf, o[dt]);
          }
        }
    }
    if (MODE == 0) { int dn = __all(carry < -110.f) ? 1 : 0; if (lane == 0) flags[w] = dn; }
    kt = nkt;
  }
#undef ATT_LOAD
  if (MODE != 0) {
    l += __shfl_xor(l, 32);
    const float il = 1.f / l;
#pragma unroll
    for (int dt = 0; dt < 2; ++dt)
#pragma unroll
      for (int i = 0; i < 16; ++i) o[dt][i] *= il;
  }
}

DI void attn_store(bfu* __restrict__ yrow  , const f32x16 (&o)[2], int hh) {
#pragma unroll
  for (int dt = 0; dt < 2; ++dt)
#pragma unroll
    for (int g = 0; g < 4; ++g) {
      u32x2 v = {pk2(o[dt][4 * g], o[dt][4 * g + 1]), pk2(o[dt][4 * g + 2], o[dt][4 * g + 3])};
      *(u32x2*)(yrow + 32 * dt + 8 * g + 4 * hh) = v;
    }
}

template <int MODE>
DI void attn_item(const Params& p, int idx, char* smem) {
  const int tid = TID(), lane = tid & 63, w = tid >> 6, r = lane & 31, hh = lane >> 5;
  const int qt = 15 - (idx >> 5); const int bh = idx & 31, b = bh >> 2, h = bh & 3;
  const int spos = qt * 128 + w * 32 + r;
  const size_t t = (size_t)b * S + spos;
  __syncthreads();
  if (tid < 4) ((int*)(smem + AT_FLAGS))[tid] = 0;
  f32x16 o[2];
  if (MODE == 0) {
    attn_run<0>(p.q_sb + (size_t)bh * S * 64, p.k_sb + (size_t)bh * S * 64, p.vt_sb + (size_t)bh * 64 * S, qt, o, nullptr, 0u, 0u, smem);
    attn_store(p.y + t * 1024 + 0 * 256 + h * 64, o, hh);
  } else if (MODE == 1) {
    attn_run<1>(p.q_mla + (size_t)bh * S * 96, p.k_mla + (size_t)bh * S * 96, p.vt_mla + (size_t)bh * 64 * S, qt, o, nullptr, 0u, 0u, smem);
    attn_store(p.y + t * 1024 + 1 * 256 + h * 64, o, hh);
  } else if (MODE == 2) {
    attn_run<2>(p.q_fox + (size_t)bh * S * 64, p.k_fox + (size_t)bh * S * 64, p.vt_fox + (size_t)bh * 64 * S, qt, o, p.cum + (size_t)bh * S, 0u, 0u, smem);
    attn_store(p.y + t * 1024 + 3 * 256 + h * 64, o, hh);
  } else {
    float* lut = (float*)(smem + AT_LUT);
    unsigned* sor = (unsigned*)(smem + AT_OR);
    if (tid == 0) *sor = 0u;
    if (tid < 129) lut[tid] = p.rel_bias[rel_bucket_dev(tid) * 4 + h];
    __syncthreads();
    const unsigned sel = p.selmask[t];
    atomicOr(sor, sel);
    __syncthreads();
    const unsigned bm = *sor;
    attn_run<3>(p.q_nsa + (size_t)bh * S * 64, p.ks + (size_t)b * S * 64, p.vts + (size_t)b * 64 * S, qt, o, nullptr, sel, bm, smem);
    const float g1 = sigmoidf_(p.small_[t * 16 + 4 + h]);
    const float g2 = sigmoidf_(p.small_[t * 16 + 8 + h]);
    f32x16 tot[2];
    const float* oc = p.ocmp + (t * 4 + h) * 64;
#pragma unroll
    for (int dt = 0; dt < 2; ++dt)
#pragma unroll
      for (int g = 0; g < 4; ++g) {
        float4 c4 = *(const float4*)(oc + 32 * dt + 8 * g + 4 * hh);
        tot[dt][4 * g] = c4.x + g1 * o[dt][4 * g]; tot[dt][4 * g + 1] = c4.y + g1 * o[dt][4 * g + 1];
        tot[dt][4 * g + 2] = c4.z + g1 * o[dt][4 * g + 2]; tot[dt][4 * g + 3] = c4.w + g1 * o[dt][4 * g + 3];
      }
    attn_run<4>(p.q_nsa + (size_t)bh * S * 64, p.kw + (size_t)b * S * 64, p.vtw + (size_t)b * 64 * S, qt, o, nullptr, 0u, 0u, smem);
#pragma unroll
    for (int dt = 0; dt < 2; ++dt)
#pragma unroll
      for (int i = 0; i < 16; ++i) tot[dt][i] += g2 * o[dt][i];
    attn_store(p.y + t * 1024 + 2 * 256 + h * 64, tot, hh);
  }
}

DI void phase_attn1(const Params& p, int L, char* smem) {
  const int extra = (L > 0) ? CV_NC : 0;
  for (int it = blockIdx.x; it < 1792 + extra; it += gridDim.x) {
    if (it < 512) attn_item<2>(p, it, smem);
    else if (it < 1024) nsacmp_item(p, L, it - 512, smem);
    else if (it < 1536) attn_item<0>(p, it - 1024, smem);
    else if (it < 1792) mlaprep_item(p, L, it - 1536, smem);
    else conv_item_C(p, L, it - 1792, smem);
  }
}
DI void phase_attn2(const Params& p, char* smem) {
  for (int it = blockIdx.x; it < 1024; it += gridDim.x) {
    const int j = (it & 511) >> 1;
    const int idx = (it < 512) ? j : (511 - j);
    if (it & 1) attn_item<1>(p, idx, smem); else attn_item<3>(p, idx, smem);
  }
}

DI void phase_widen(const Params& p, char* smem) {
  GEMM_IDS
  for (int id = blockIdx.x; id < 128 * 8; id += gridDim.x) {
    int tm, tn; map_tile(id, 8, tm, tn);
    const int m0 = tm * 128, n0 = tn * 128;
    f32x16 tot[2][2]; ZERO_ACC(tot)
    f32x16 acc[2][2]; ZERO_ACC(acc)
    auto flush = [&](int n) {
      EPI_BEGIN(acc) tot[mt][nt][i] += v * bf2f(p.gates[(size_t)row * 4096 + n * 1024 + col]); acc[mt][nt][i] = 0.f; EPI_END
    };
    gemm_core_h<false, true, 2, 4>(p.y, 1024, p.wt_br, 1024, 1024, m0, n0, acc, smem, flush);
    EPI_BEGIN(tot) p.u[(size_t)row * 1024 + col] = f2bf(v); EPI_END
  }
}
DI void phase_resid(const Params& p, const bfu* A, int lda, const bfu* Bt, int K, char* smem) {
  GEMM_IDS
  for (int id = blockIdx.x; id < 64 * 8; id += gridDim.x) {
    int tm, tn; map_tile(id, 8, tm, tn);
    const int m0 = tm * 256, n0 = tn * 128;
    f32x16 acc[4][2]; ZERO_ACCM(acc, 4)
    gemm_core<false, false, 4>(A, lda, Bt, K, K, m0, n0, acc, smem);
    EPI_BEGINM(acc, 4)
      float* xp = p.out + (size_t)row * 1024 + col;
      float nv = *xp + v; *xp = nv; p.xb[(size_t)row * 1024 + col] = f2bf(nv);
    EPI_END
  }
}
DI void phase_up(const Params& p, char* smem) {
  GEMM_IDS
  for (int id = blockIdx.x; id < 64 * 32; id += gridDim.x) {
    int tm, tn; map_tile(id, 32, tm, tn);
    const int m0 = tm * 256, n0 = tn * 128;
    f32x16 acc[4][2]; ZERO_ACCM(acc, 4)
    gemm_core<true, false, 4>(p.xb, D, p.wt_up, D, D, m0, n0, acc, smem);
    STORE_TILE_BF16(acc, 4, p.ff, DFF, 0, fmaxf(v * rs, 0.f) * fmaxf(v * rs, 0.f))
  }
}
DI void phase_ple(const Params& p, int L, char* smem) {
  GEMM_IDS
  for (int id = blockIdx.x; id < 128 * 8; id += gridDim.x) {
    int tm, tn; map_tile(id, 8, tm, tn);
    const int m0 = tm * 128, n0 = tn * 128;
    f32x16 gt[2][2]; ZERO_ACC(gt)
    gemm_core<true>(p.xb, D, p.wt_pg, D, D, m0, n0, gt, smem);
    EPI_BEGIN(gt) gt[mt][nt][i] = sigmoidf_(v * rstd_s[rl]); EPI_END
    f32x16 acc[2][2]; ZERO_ACC(acc)
    gemm_core<false, false>(p.pb, 256, p.wt_pp, 256, 256, m0, n0, acc, smem);
    EPI_BEGIN(acc)
      float* xp = p.out + (size_t)row * 1024 + col;
      float nv = *xp + gt[mt][nt][i] * v; *xp = nv; p.xb2[(size_t)row * 1024 + col] = f2bf(nv);
    EPI_END
  }
  if (L + 1 < 4) {
    __syncthreads();
    for (int it = blockIdx.x; it < CV_NA + CV_NB; it += gridDim.x) {
      if (it < CV_NA) conv_item_A(p, L + 1, it, smem); else conv_item_B(p, L + 1, it - CV_NA, smem);
    }
  }
}

DI void grid_barrier() { cg::this_grid().sync(); }
DI void grid_barrier_light(unsigned* ctr, unsigned target) {
  asm volatile("s_waitcnt vmcnt(0)" ::: "memory");
  __syncthreads();
  if (TID() == 0) {
    __builtin_amdgcn_fence(__ATOMIC_RELEASE, "agent");
    asm volatile("s_waitcnt vmcnt(0)" ::: "memory");
    __hip_atomic_fetch_add(ctr, 1u, __ATOMIC_RELAXED, __HIP_MEMORY_SCOPE_AGENT);
    while (__hip_atomic_load(ctr, __ATOMIC_RELAXED, __HIP_MEMORY_SCOPE_AGENT) < target) __builtin_amdgcn_s_sleep(1);
    __builtin_amdgcn_fence(__ATOMIC_ACQUIRE, "agent");
    asm volatile("s_waitcnt vmcnt(0)" ::: "memory");
  }
  __syncthreads();
}

__global__ void __launch_bounds__(256, 2) hybrid_megakernel(Params p) {
  __shared__ __attribute__((aligned(16))) char smem[SMEM_BYTES];
  unsigned epoch = 0;
  for (int ph = p.ph_lo; ph < p.ph_hi; ++ph) {
    const int L = ph / NPH, s = ph % NPH;
    if (s == 0 && L > 0) continue;
#ifdef ONLY
    if (s != ONLY) continue;
#endif
    switch (s) {
      case 0: phase_convert(p, L, smem); break;
      case 1: phase_in(p, L, smem); break;
      case 2: phase_prep(p, L, smem); break;
      case 3: phase_attn1(p, L, smem); break;
      case 4: phase_attn2(p, smem); break;
      case 5: phase_widen(p, smem); break;
      case 6: phase_resid(p, p.u, 1024, p.wt_o, 1024, smem); break;
      case 7: phase_up(p, smem); break;
      case 8: phase_resid(p, p.ff, DFF, p.wt_down, DFF, smem); break;
      case 9: phase_ple(p, L, smem); break;
    }
    if (ph + 1 < p.ph_hi) {
      if (ph == p.ph_lo) grid_barrier();
      else { ++epoch; grid_barrier_light(p.bar, epoch * gridDim.x); }
    }
  }
}

extern "C" void kernel_launch(void* const* d_in, const int* in_sizes, int n_in, void* d_out, int out_size, void* d_ws,
                              size_t ws_size, hipStream_t stream) {
  Params p;
  memset(&p, 0, sizeof(p));
  const float* const* in = (const float* const*)d_in;
  p.x = in[0]; p.p = in[1]; p.rel_bias = in[2]; p.norm_mix_g = in[3]; p.w_in = in[4]; p.mla_cq_g = in[5]; p.mla_ckv_g = in[6];
  p.mla_w_uq = in[7]; p.mla_w_ukv = in[8]; p.mla_qn_g = in[9]; p.mla_kn_g = in[10]; p.nsa_pe_k = in[11]; p.nsa_pe_v = in[12];
  p.nsa_w1_k = in[13]; p.nsa_w2_k = in[14]; p.nsa_w1_v = in[15]; p.nsa_w2_v = in[16]; p.nsa_qn_g = in[17]; p.nsa_kn_g = in[18];
  p.fox_f_bias = in[19]; p.fox_qn_g = in[20]; p.fox_kn_g = in[21]; p.w_branch = in[22]; p.w_o = in[23]; p.norm_mlp_g = in[24];
  p.w_up = in[25]; p.w_down = in[26]; p.norm_ple_g = in[27]; p.w_ple_gate = in[28]; p.w_ple_proj = in[29];
  p.out = (float*)d_out;
  char* ws = (char*)d_ws; size_t off = 0;
  auto take = [&](size_t bytes) { char* r = ws + off; off += (bytes + 255) & ~(size_t)255; return r; };
  p.wt_in = (bfu*)take((size_t)NINP * D * 2);
  p.wt_uq = (bfu*)take(384 * 384 * 2);
  p.wt_ukv = (bfu*)take(512 * 128 * 2);
  p.wt_br = (bfu*)take((size_t)4 * D * 256 * 2);
  p.wt_o = (bfu*)take((size_t)D * D * 2);
  p.wt_up = (bfu*)take((size_t)DFF * D * 2);
  p.wt_down = (bfu*)take((size_t)D * DFF * 2);
  p.wt_pg = (bfu*)take((size_t)D * D * 2);
  p.wt_pp = (bfu*)take((size_t)D * 256 * 2);
  p.xb = (bfu*)take((size_t)M * D * 2);
  p.pb = (bfu*)take((size_t)M * 256 * 2);
  char* projr = take((size_t)M * PJ * 2);
  p.proj = (bfu*)projr;
  p.cq = p.xb; p.ckv = p.xb + (size_t)M * 384;
  p.gates = (bfu*)take((size_t)M * 4096 * 2);
  p.ff = p.gates;
  p.y = (bfu*)take((size_t)M * D * 2);
  p.qraw = (bfu*)take((size_t)M * 384 * 2);
  p.kvraw = (bfu*)take((size_t)M * 512 * 2);
  p.small_ = (float*)take((size_t)M * 16 * 4);
  p.kcmp = (bfu*)take((size_t)(M + 32) * 64 * 2); p.vcmp = (bfu*)take((size_t)(M + 32) * 64 * 2);
  p.wt_w1 = (bfu*)take((size_t)2 * 128 * 2048 * 2);
  p.pebias = (float*)take(16 * 64 * 4);
  p.krope = (bfu*)take((size_t)M * 32 * 2);
  p.xb2 = p.y;
  p.q_sb = (bfu*)take((size_t)M * 256 * 2); p.k_sb = (bfu*)take((size_t)M * 256 * 2); p.vt_sb = (bfu*)take((size_t)M * 256 * 2);
  p.q_fox = (bfu*)take((size_t)M * 256 * 2); p.k_fox = (bfu*)take((size_t)M * 256 * 2); p.vt_fox = (bfu*)take((size_t)M * 256 * 2);
  p.q_nsa = (bfu*)take((size_t)M * 256 * 2);
  p.ks = (bfu*)take((size_t)M * 64 * 2); p.vts = (bfu*)take((size_t)M * 64 * 2); p.kw = (bfu*)take((size_t)M * 64 * 2); p.vtw = (bfu*)take((size_t)M * 64 * 2);
  p.cum = (float*)take((size_t)NB * H * S * 4);
  p.kc = (float*)take((size_t)NB * 128 * 64 * 4); p.vc = (float*)take((size_t)NB * 128 * 64 * 4);
  p.kc_b = (bfu*)take((size_t)NB * 128 * 64 * 2); p.vct_b = (bfu*)take((size_t)NB * 64 * 128 * 2);
  p.selmask = (unsigned*)take((size_t)M * 4);
  p.bar = (unsigned*)take(256);
  {
    size_t o2 = 0;
    p.u = (bfu*)(projr + o2); o2 += (size_t)M * D * 2;
    p.q_mla = (bfu*)(projr + o2); o2 += (size_t)M * 384 * 2;
    p.k_mla = (bfu*)(projr + o2); o2 += (size_t)M * 384 * 2;
    p.vt_mla = (bfu*)(projr + o2); o2 += (size_t)M * 256 * 2;
    p.ocmp = (float*)(projr + o2); o2 += (size_t)M * 256 * 4;
    if (o2 > (size_t)M * PJ * 2) fprintf(stderr, "alias overflow\n");
  }
  if (off > ws_size) fprintf(stderr, "workspace too small: need %zu have %zu\n", off, ws_size);

  static int grid_blocks = 0;
  if (!grid_blocks) {
    int dev = 0, cus = 0, per_cu = 0;
    hipGetDevice(&dev);
    hipDeviceGetAttribute(&cus, hipDeviceAttributeMultiprocessorCount, dev);
    hipOccupancyMaxActiveBlocksPerMultiprocessor(&per_cu, hybrid_megakernel, 256, 0);
    if (per_cu > 2) per_cu = 2;
    if (per_cu < 1) per_cu = 1;
    grid_blocks = cus * per_cu;
  }
#if MULTI
  for (int ph = 0; ph < 4 * NPH; ++ph) {
    p.ph_lo = ph; p.ph_hi = ph + 1;
    hipLaunchKernelGGL(hybrid_megakernel, dim3(grid_blocks), dim3(256), 0, stream, p);
  }
#else
  p.ph_lo = 0; p.ph_hi = 4 * NPH;
  hipMemsetAsync(p.bar, 0, 256, stream);
  void* args[] = {&p};
  hipError_t e = hipLaunchCooperativeKernel((void*)hybrid_megakernel, dim3(grid_blocks), dim3(256), args, 0, stream);
  if (e != hipSuccess) fprintf(stderr, "cooperative launch failed: %s (grid %d)\n", hipGetErrorString(e), grid_blocks);
#endif
}
```

```cpp
#include <hip/hip_runtime.h>
#include <hip/hip_cooperative_groups.h>
#include <cstdio>
#include <cstdint>
#include <cstring>
namespace cg = cooperative_groups;

#ifndef FUSE_MASK
#define FUSE_MASK 1
#endif
#ifndef MULTI
#define MULTI 0
#endif

typedef unsigned short bfu;
using bf16x8 = __attribute__((ext_vector_type(8))) short;
using s16x4  = __attribute__((ext_vector_type(4))) short;
using f32x16 = __attribute__((ext_vector_type(16))) float;
using u32x4  = __attribute__((ext_vector_type(4))) unsigned;
using u32x2  = __attribute__((ext_vector_type(2))) unsigned;
#define DI __device__ __forceinline__
#define MFMA(a, b, c) __builtin_amdgcn_mfma_f32_32x32x16_bf16((a), (b), (c), 0, 0, 0)

constexpr int NB = 8, S = 2048, D = 1024, M = NB * S, H = 4;
constexpr int NIN = 6832, NINP = 6912, PJ = 2752, PJN = 2736;
constexpr int DFF = 4096;
constexpr float EPS = 1e-6f;
constexpr int SMEM_BYTES = 60 * 1024;
constexpr int NPH = 10;

struct Params {
  const float *x, *p, *rel_bias, *norm_mix_g, *w_in, *mla_cq_g, *mla_ckv_g, *mla_w_uq, *mla_w_ukv, *mla_qn_g, *mla_kn_g;
  const float *nsa_pe_k, *nsa_pe_v, *nsa_w1_k, *nsa_w2_k, *nsa_w1_v, *nsa_w2_v, *nsa_qn_g, *nsa_kn_g;
  const float *fox_f_bias, *fox_qn_g, *fox_kn_g, *w_branch, *w_o, *norm_mlp_g, *w_up, *w_down, *norm_ple_g, *w_ple_gate, *w_ple_proj;
  float* out;
  bfu *wt_in, *wt_uq, *wt_ukv, *wt_br, *wt_o, *wt_up, *wt_down, *wt_pg, *wt_pp;
  bfu *xb, *xb2, *krope, *pb, *kcmp, *vcmp, *wt_w1, *kc_b, *vct_b, *cq, *ckv, *proj, *gates, *ff, *y, *u, *qraw, *kvraw;
  float* small_;
  bfu *q_sb, *k_sb, *vt_sb, *q_fox, *k_fox, *vt_fox, *q_nsa, *ks, *vts, *kw, *vtw, *q_mla, *k_mla, *vt_mla;
  float *cum, *kc, *vc, *ocmp, *pebias;
  unsigned* selmask;
  int ph_lo, ph_hi;
  unsigned* bar;
};

DI int TID() { int t = threadIdx.x; asm volatile("" : "+v"(t)); return t; }
DI bfu f2bf(float f) { __bf16 h = (__bf16)f; return __builtin_bit_cast(bfu, h); }
DI float bf2f(bfu b) { return __uint_as_float(((unsigned)b) << 16); }
typedef float f32x2_t __attribute__((ext_vector_type(2)));
typedef __bf16 bf16x2_t __attribute__((ext_vector_type(2)));
DI unsigned pk2(float a, float b) { f32x2_t v = {a, b}; bf16x2_t r_ = __builtin_convertvector(v, bf16x2_t); return __builtin_bit_cast(unsigned, r_); }
DI float bflo(unsigned u) { return __uint_as_float(u << 16); }
DI float bfhi(unsigned u) { return __uint_as_float(u & 0xffff0000u); }
DI float sigmoidf_(float v) { return 1.f / (1.f + __expf(-v)); }

#define PACK8(vec, base) __builtin_bit_cast(bf16x8, (u32x4){pk2((vec)[(base)+0], (vec)[(base)+1]), pk2((vec)[(base)+2], (vec)[(base)+3]), pk2((vec)[(base)+4], (vec)[(base)+5]), pk2((vec)[(base)+6], (vec)[(base)+7])})

DI int in_colmap(int n) {
  if (n < 1280) return n;
  if (n < 1920) return n + 32;
  if (n < 2688) return n + 44;
  if (n < 2720) return n - 2688 + 1280;
  if (n < 2732) return n - 2720 + 1952;
  if (n < 2736) return n;
  if (n < 2752) return -1;
  if (n < 6848) return n - 16;
  return -1;
}
template <bool MAP = false>
DI void conv_tile(const float* __restrict__ src, int N, int K, bfu* __restrict__ dst, const float* __restrict__ g,
                  int tk, int tn, char* smem, int ldk = -1) {
  const int LK = ldk < 0 ? K : ldk;
  float* T = (float*)smem;
  const int tid = TID();
  __syncthreads();
#pragma unroll
  for (int j = 0; j < 4; ++j) {
    int k = (tid >> 4) + 16 * j, n4 = (tid & 15) * 4;
    int gn = tn * 64 + n4, gk = tk * 64 + k;
    float4 v = make_float4(0.f, 0.f, 0.f, 0.f);
    const int og = MAP ? in_colmap(gn) : (gn < N ? gn : -1);
    if (og >= 0) v = *(const float4*)(src + (size_t)gk * N + og);
    float gg = g ? g[gk] : 1.f;
    T[k * 65 + n4 + 0] = v.x * gg; T[k * 65 + n4 + 1] = v.y * gg; T[k * 65 + n4 + 2] = v.z * gg; T[k * 65 + n4 + 3] = v.w * gg;
  }
  __syncthreads();
#pragma unroll
  for (int j = 0; j < 2; ++j) {
    int n = (tid >> 3) + 32 * j, kc = tid & 7;
    float e[8];
#pragma unroll
    for (int q = 0; q < 8; ++q) e[q] = T[(kc * 8 + q) * 65 + n];
    u32x4 o = {pk2(e[0], e[1]), pk2(e[2], e[3]), pk2(e[4], e[5]), pk2(e[6], e[7])};
    *(u32x4*)(dst + (size_t)(tn * 64 + n) * LK + tk * 64 + kc * 8) = o;
  }
}

constexpr int CV_NA = 16 * 108, CV_NB = 36 + 16 + 128 + 16, CV_NC = 256 + 256 + 1024 + 1024 + 256 + 64 + 2048, CV_NX = M * D / 2048;
DI void conv_item_A(const Params& p, int L, int t, char* smem) {
  conv_tile<true>(p.w_in + (size_t)L * D * NIN, NIN, D, p.wt_in, p.norm_mix_g + L * D, t / 108, t % 108, smem);
}
DI void conv_item_B(const Params& p, int L, int it, char* smem) {
  if (it < 36) { conv_tile(p.mla_w_uq + (size_t)L * 384 * 384, 384, 384, p.wt_uq, p.mla_cq_g + L * 384, it / 6, it % 6, smem); }
  else if (it < 52) { int t = it - 36; conv_tile(p.mla_w_ukv + (size_t)L * 128 * 512, 512, 128, p.wt_ukv, p.mla_ckv_g + L * 128, t / 8, t % 8, smem); }
  else if (it < 180) { int t = it - 52; int kv = t >> 6; t &= 63;
    conv_tile((kv ? p.nsa_w1_v : p.nsa_w1_k) + (size_t)L * 2048 * 64, 64, 2048, p.wt_w1 + (size_t)kv * 128 * 2048, nullptr, t >> 1, t & 1, smem); }
  else {
    const int q = it - 180; const int kv = q >> 3, kr = q & 7; const int tid = TID(); const int n = tid & 63, kq = tid >> 6;
    const float* w1 = (kv ? p.nsa_w1_v : p.nsa_w1_k) + (size_t)L * 2048 * 64;
    const float* pe = (kv ? p.nsa_pe_v : p.nsa_pe_k) + (size_t)L * 2048;
    float a = 0.f;
    const int kb = kr * 256 + kq * 64;
#pragma unroll 16
    for (int k = kb; k < kb + 64; ++k) a += pe[k] * w1[(size_t)k * 64 + n];
    float* red = (float*)smem;
    __syncthreads(); red[tid] = a; __syncthreads();
    if (tid < 64) p.pebias[(kv * 8 + kr) * 64 + tid] = (red[tid] + red[tid + 64]) + (red[tid + 128] + red[tid + 192]);
  }
}
DI void conv_item_C(const Params& p, int L, int it, char* smem) {
  if (it < 256) { int t = it; int n = t >> 6; t &= 63; conv_tile(p.w_branch + ((size_t)L * 4 + n) * 256 * D, D, 256, p.wt_br + (size_t)n * 256, nullptr, t / 16, t % 16, smem, 1024); }
  else if (it < 512) { int t = it - 256; conv_tile(p.w_o + (size_t)L * D * D, D, D, p.wt_o, nullptr, t / 16, t % 16, smem); }
  else if (it < 1536) { int t = it - 512; conv_tile(p.w_up + (size_t)L * D * DFF, DFF, D, p.wt_up, p.norm_mlp_g + L * D, t / 64, t % 64, smem); }
  else if (it < 2560) { int t = it - 1536; conv_tile(p.w_down + (size_t)L * DFF * D, D, DFF, p.wt_down, nullptr, t / 16, t % 16, smem); }
  else if (it < 2816) { int t = it - 2560; conv_tile(p.w_ple_gate + (size_t)L * D * D, D, D, p.wt_pg, p.norm_ple_g + L * D, t / 16, t % 16, smem); }
  else if (it < 2880) { int t = it - 2816; conv_tile(p.w_ple_proj + (size_t)L * 256 * D, D, 256, p.wt_pp, nullptr, t / 16, t % 16, smem); }
  else {
    size_t e = (size_t)(it - 2880) * 2048 + TID() * 8;
    const float* sp = p.p + (size_t)L * M * 256 + e;
    float4 a = *(const float4*)sp, b = *(const float4*)(sp + 4);
    *(u32x4*)(p.pb + e) = (u32x4){pk2(a.x, a.y), pk2(a.z, a.w), pk2(b.x, b.y), pk2(b.z, b.w)};
  }
}
DI void phase_convert(const Params& p, int L, char* smem) {
  const int total = CV_NA + CV_NB + CV_NC + CV_NX;
  for (int it = blockIdx.x; it < total; it += gridDim.x) {
    if (it < CV_NA) conv_item_A(p, L, it, smem);
    else if (it < CV_NA + CV_NB) conv_item_B(p, L, it - CV_NA, smem);
    else if (it < CV_NA + CV_NB + CV_NC) conv_item_C(p, L, it - CV_NA - CV_NB, smem);
    else {
      size_t e = (size_t)(it - CV_NA - CV_NB - CV_NC) * 2048 + TID() * 8;
      float4 a = *(const float4*)(p.x + e), b = *(const float4*)(p.x + e + 4);
      *(float4*)(p.out + e) = a; *(float4*)(p.out + e + 4) = b;
      *(u32x4*)(p.xb2 + e) = (u32x4){pk2(a.x, a.y), pk2(a.z, a.w), pk2(b.x, b.y), pk2(b.z, b.w)};
    }
  }
}

#define BAR_LDS() do { asm volatile("s_waitcnt lgkmcnt(0)" ::: "memory"); __builtin_amdgcn_s_barrier(); asm volatile("" ::: "memory"); } while (0)
constexpr int GP = 72;
constexpr int RSTD_OFF = 55296;
struct NoHook { DI void operator()(int) const {} };
template <bool NORM, bool DEEP, int MTW, int KSEG, class HOOK>
DI void gemm_core_h(const bfu* __restrict__ A, int lda, const bfu* __restrict__ Bt, int ldb, int K, int m0, int n0,
                    f32x16 (&acc)[MTW][2], char* smem, HOOK hook) {
  constexpr int NA = 2 * MTW;
  bfu* As = (bfu*)smem;
  bfu* Bs = As + 64 * MTW * GP;
  float* rstd_s = (float*)(smem + RSTD_OFF);
  const int tid = TID(), lane = tid & 63, w = tid >> 6, r = lane & 31, hh = lane >> 5;
  const int wm = w >> 1, wn = w & 1;
  const int lrow = tid >> 3, lkc = tid & 7;
  const unsigned aoff = (unsigned)((m0 + lrow) * lda + lkc * 8);
  const unsigned boff = (unsigned)((n0 + lrow) * ldb + lkc * 8);
#define AP_(j, k64) (A + (aoff + (unsigned)(32 * (j)) * (unsigned)lda + (unsigned)(k64)))
#define BP_(j, k64) (Bt + (boff + (unsigned)(32 * (j)) * (unsigned)ldb + (unsigned)(k64)))
  u32x4 ra0[NA], rb0[4], ra1[NA], rb1[4];
  float ssq[NA];
#pragma unroll
  for (int j = 0; j < NA; ++j) ssq[j] = 0.f;
  const int nk = K >> 6;
#pragma unroll
  for (int j = 0; j < NA; ++j) ra0[j] = *(const u32x4*)AP_(j, 0);
#pragma unroll
  for (int j = 0; j < 4; ++j) rb0[j] = *(const u32x4*)BP_(j, 0);
  if (DEEP) {
#pragma unroll
    for (int j = 0; j < NA; ++j) ra1[j] = *(const u32x4*)AP_(j, 64);
#pragma unroll
    for (int j = 0; j < 4; ++j) rb1[j] = *(const u32x4*)BP_(j, 64);
  }
#define GEMM_STEP(RA, RB, KT, DIST)                                                                                \
  {                                                                                                                \
    BAR_LDS();                                                                                                     \
    _Pragma("unroll") for (int j = 0; j < NA; ++j) *(u32x4*)(As + (lrow + 32 * j) * GP + lkc * 8) = RA[j];         \
    _Pragma("unroll") for (int j = 0; j < 4; ++j) *(u32x4*)(Bs + (lrow + 32 * j) * GP + lkc * 8) = RB[j];          \
    if (NORM) {                                                                                                    \
      _Pragma("unroll") for (int j = 0; j < NA; ++j) _Pragma("unroll") for (int e = 0; e < 4; ++e) {               \
        float lo = bflo(RA[j][e]), hi = bfhi(RA[j][e]); ssq[j] += lo * lo + hi * hi; }                             \
    }                                                                                                              \
    BAR_LDS();                                                                                                     \
    {                                                                                                              \
      const int kn_ = ((KT) + (DIST) < nk) ? ((KT) + (DIST)) : (nk - 1);       \
      _Pragma("unroll") for (int j = 0; j < NA; ++j) RA[j] = *(const u32x4*)AP_(j, kn_ * 64);                      \
      _Pragma("unroll") for (int j = 0; j < 4; ++j) RB[j] = *(const u32x4*)BP_(j, kn_ * 64);                       \
    }                                                                                                              \
    _Pragma("unroll") for (int ks = 0; ks < 4; ++ks) {                                                             \
      bf16x8 b0 = *(const bf16x8*)(Bs + (wn * 64 + r) * GP + ks * 16 + hh * 8);                                    \
      bf16x8 b1 = *(const bf16x8*)(Bs + (wn * 64 + 32 + r) * GP + ks * 16 + hh * 8);                               \
      _Pragma("unroll") for (int mt = 0; mt < MTW; ++mt) {                                                         \
        bf16x8 a_ = *(const bf16x8*)(As + (wm * 32 * MTW + mt * 32 + r) * GP + ks * 16 + hh * 8);                  \
        acc[mt][0] = MFMA(a_, b0, acc[mt][0]); acc[mt][1] = MFMA(a_, b1, acc[mt][1]);                              \
      }                                                                                                            \
    }                                                                                                              \
  }
  if (DEEP) {
    for (int kt = 0; kt < nk; kt += 2) {
      GEMM_STEP(ra0, rb0, kt, 2)
      GEMM_STEP(ra1, rb1, kt + 1, 2)
    }
  } else {
    for (int kt = 0; kt < nk; ++kt) {
      GEMM_STEP(ra0, rb0, kt, 1)
      if (KSEG > 0) { if (((kt + 1) % (KSEG > 0 ? KSEG : 1)) == 0) hook((kt + 1) / (KSEG > 0 ? KSEG : 1) - 1); }
    }
  }
#undef GEMM_STEP
#undef AP_
#undef BP_
  if (NORM) {
#pragma unroll
    for (int j = 0; j < NA; ++j) {
      float v = ssq[j];
      v += __shfl_xor(v, 1); v += __shfl_xor(v, 2); v += __shfl_xor(v, 4);
      if (lkc == 0) rstd_s[lrow + 32 * j] = rsqrtf(v / (float)K + EPS);
    }
  }
  __syncthreads();
}

template <bool NORM, bool DEEP = true, int MTW = 2>
DI void gemm_core(const bfu* __restrict__ A, int lda, const bfu* __restrict__ Bt, int ldb, int K, int m0, int n0,
                  f32x16 (&acc)[MTW][2], char* smem) {
  gemm_core_h<NORM, DEEP, MTW, 0, NoHook>(A, lda, Bt, ldb, K, m0, n0, acc, smem, NoHook());
}

#define ZERO_ACC(a) ZERO_ACCM(a, 2)
#define ZERO_ACCM(a, MT) _Pragma("unroll") for (int _m = 0; _m < MT; ++_m) _Pragma("unroll") for (int _n = 0; _n < 2; ++_n) _Pragma("unroll") for (int _i = 0; _i < 16; ++_i) a[_m][_n][_i] = 0.f;

#define EPI_BEGIN(accv) EPI_BEGINM(accv, 2)
#define EPI_BEGINM(accv, MT)                                                                                    \
  _Pragma("unroll") for (int mt = 0; mt < MT; ++mt) _Pragma("unroll") for (int nt = 0; nt < 2; ++nt)              \
  _Pragma("unroll") for (int i = 0; i < 16; ++i) {                                                              \
    const int rl = wm * 32 * MT + mt * 32 + (i & 3) + 8 * (i >> 2) + 4 * hh;                                      \
    const int row = m0 + rl; const int col = n0 + wn * 64 + nt * 32 + r; float v = accv[mt][nt][i];               \
    (void)rl; (void)row; (void)col; (void)v;
#define EPI_END }

#define GEMM_IDS const int tid = TID(), lane = tid & 63, w = tid >> 6, r = lane & 31, hh = lane >> 5, wm = w >> 1, wn = w & 1; \
  const float* rstd_s = (const float*)(smem + RSTD_OFF); (void)rstd_s; (void)r; (void)hh; (void)wm; (void)wn;

DI void map_tile(int id, int NT, int& mt, int& nt) {
  int x = id & 7, idx = id >> 3;
  int srl = idx / (8 * NT), rem = idx % (8 * NT);
  nt = rem >> 3; int mi = rem & 7;
  mt = (srl * 8 + x) * 8 + mi;
}

#define STORE_TILE_BF16(accv, MT, BASE, LD, COLOFF, OP)                                                           \
  _Pragma("unroll") for (int mt = 0; mt < MT; ++mt) _Pragma("unroll") for (int ip = 0; ip < 8; ++ip) {             \
    const int i0 = 2 * ip;                                                                                        \
    const int rl0 = wm * 32 * MT + mt * 32 + (i0 & 3) + 8 * (i0 >> 2) + 4 * hh;                                    \
    const float rs0 = rstd_s[rl0], rs1 = rstd_s[rl0 + 1]; (void)rs0; (void)rs1;                                    \
    _Pragma("unroll") for (int nt = 0; nt < 2; ++nt) {                                                            \
      float va; { const float v = accv[mt][nt][i0]; const float rs = rs0; (void)rs; va = (OP); }                   \
      float vb; { const float v = accv[mt][nt][i0 + 1]; const float rs = rs1; (void)rs; vb = (OP); }               \
      const float snd = (r & 1) ? va : vb;                                                                        \
      const float rcv = __shfl_xor(snd, 1);                                                                       \
      const unsigned pk_ = (r & 1) ? pk2(rcv, vb) : pk2(va, rcv);                                                  \
      const unsigned off_ = (unsigned)(m0 + rl0 + (r & 1)) * (unsigned)(LD) + (unsigned)((COLOFF) + n0 + wn * 64 + nt * 32 + (r & ~1)); \
      *(unsigned*)((BASE) + off_) = pk_;                                                                          \
    }                                                                                                             \
  }

DI void phase_in(const Params& p, int L, char* smem) {
  GEMM_IDS
  const int NT = NINP / 128;
  for (int id = blockIdx.x; id < 64 * NT; id += gridDim.x) {
    int tm, tn; map_tile(id, NT, tm, tn);
    const int m0 = tm * 256, n0 = tn * 128;
    f32x16 acc[4][2]; ZERO_ACCM(acc, 4)
    gemm_core<true, false, 4>(p.xb2, D, p.wt_in, D, D, m0, n0, acc, smem);
    const int cb = (n0 >> 6) + wn;
    const int b = m0 >> 11;
    const int sb = (m0 & (S - 1)) + wm * 128;
#pragma unroll
    for (int mt = 0; mt < 4; ++mt)
#pragma unroll
      for (int i = 0; i < 16; ++i) {
        const float rs = rstd_s[wm * 128 + mt * 32 + (i & 3) + 8 * (i >> 2) + 4 * hh];
        acc[mt][0][i] *= rs; acc[mt][1][i] *= rs;
      }
    int grp_;
    if (cb >= 43) grp_ = 16;
    else if (cb < 8) grp_ = 1;
    else if ((cb >= 20 && cb < 24) || cb == 26 || cb == 28 || (cb >= 30 && cb < 38)) grp_ = 2;
    else if ((cb >= 8 && cb < 12) || cb == 27 || cb == 29 || (cb >= 38 && cb < 42)) grp_ = 4;
    else grp_ = 8;
    const bool fused_ = (grp_ == 16) || ((FUSE_MASK & grp_) != 0);
    if (!fused_) {
      EPI_BEGINM(acc, 4)
        const int oc = in_colmap(col);
        if (oc >= 0 && oc < PJN) {
          p.proj[(size_t)row * PJ + oc] = f2bf(v);
          if (oc >= 1952 && oc < 1964) p.small_[row * 16 + (oc - 1952)] = v;
          if (oc >= 2732) p.small_[row * 16 + 12 + (oc - 2732)] = v;
          if (oc >= 1568 && oc < 1632) p.kcmp[(size_t)row * 64 + (oc - 1568)] = f2bf(v);
          if (oc >= 1632 && oc < 1696) p.vcmp[(size_t)row * 64 + (oc - 1632)] = f2bf(v);
        }
      EPI_END
    } else
    if (cb >= 43) {
      if (cb < 107) {
        EPI_BEGINM(acc, 4) p.gates[(size_t)row * 4096 + (col - 2752)] = f2bf(sigmoidf_(v)); EPI_END
      }
    } else if (cb < 8 || (cb >= 20 && cb < 24) || cb == 26 || cb == 28 || (cb >= 30 && cb < 38)) {
      const float* g = nullptr; float sc = 1.f; bfu* dst;
      if (cb < 4)       { sc = 0.125f; dst = p.q_sb + ((size_t)(b * 4 + cb) * S) * 64; }
      else if (cb < 8)  { dst = p.k_sb + ((size_t)(b * 4 + cb - 4) * S) * 64; }
      else if (cb < 24) { g = p.nsa_qn_g + L * 64; sc = 0.125f; dst = p.q_nsa + ((size_t)(b * 4 + cb - 20) * S) * 64; }
      else if (cb == 26) { g = p.nsa_kn_g + (L * 3 + 1) * 64; dst = p.ks + ((size_t)b * S) * 64; }
      else if (cb == 28) { g = p.nsa_kn_g + (L * 3 + 2) * 64; dst = p.kw + ((size_t)b * S) * 64; }
      else if (cb < 34) { g = p.fox_qn_g + L * 64; sc = 0.125f; dst = p.q_fox + ((size_t)(b * 4 + cb - 30) * S) * 64; }
      else              { g = p.fox_kn_g + L * 64; dst = p.k_fox + ((size_t)(b * 4 + cb - 34) * S) * 64; }
      float g0 = sc, g1 = sc;
      if (g) { g0 = g[r] * sc; g1 = g[32 + r] * sc; }
#pragma unroll
      for (int mt = 0; mt < 4; ++mt)
#pragma unroll
        for (int i = 0; i < 16; ++i) {
          float v0 = acc[mt][0][i], v1 = acc[mt][1][i];
          float rs = 1.f;
          if (g) {
            float ss = v0 * v0 + v1 * v1;
            ss += __shfl_xor(ss, 1); ss += __shfl_xor(ss, 2); ss += __shfl_xor(ss, 4); ss += __shfl_xor(ss, 8); ss += __shfl_xor(ss, 16);
            rs = rsqrtf(ss * (1.f / 64.f) + EPS);
          }
          const int sq = sb + mt * 32 + (i & 3) + 8 * (i >> 2) + 4 * hh;
          dst[(size_t)sq * 64 + r] = f2bf(v0 * rs * g0);
          dst[(size_t)sq * 64 + 32 + r] = f2bf(v1 * rs * g1);
        }
    } else if ((cb >= 8 && cb < 12) || cb == 27 || cb == 29 || cb >= 38) {
      if (cb < 42) {
        bfu* dst;
        if (cb < 12) dst = p.vt_sb + ((size_t)(b * 4 + cb - 8) * 64) * S;
        else if (cb == 27) dst = p.vts + ((size_t)b * 64) * S;
        else if (cb == 29) dst = p.vtw + ((size_t)b * 64) * S;
        else dst = p.vt_fox + ((size_t)(b * 4 + cb - 38) * 64) * S;
#pragma unroll
        for (int mt = 0; mt < 4; ++mt)
#pragma unroll
          for (int nt = 0; nt < 2; ++nt)
#pragma unroll
            for (int g4 = 0; g4 < 4; ++g4) {
              const int sq = sb + mt * 32 + 8 * g4 + 4 * hh;
              u32x2 v = {pk2(acc[mt][nt][4 * g4], acc[mt][nt][4 * g4 + 1]), pk2(acc[mt][nt][4 * g4 + 2], acc[mt][nt][4 * g4 + 3])};
              *(u32x2*)(dst + (size_t)(nt * 32 + r) * S + sq) = v;
            }
      } else {
#pragma unroll
        for (int mt = 0; mt < 4; ++mt)
#pragma unroll
          for (int i = 0; i < 16; ++i) {
            const size_t row = (size_t)m0 + wm * 128 + mt * 32 + (i & 3) + 8 * (i >> 2) + 4 * hh;
            p.krope[row * 32 + r] = f2bf(acc[mt][0][i]);
            if (r < 16) p.small_[row * 16 + r] = acc[mt][1][i];
          }
      }
    } else {
      bfu* dst; int ld, c0;
      if (cb < 18) { dst = p.cq; ld = 384; c0 = (cb - 12) * 64; }
      else if (cb < 20) { dst = p.ckv; ld = 128; c0 = (cb - 18) * 64; }
      else if (cb == 24) { dst = p.kcmp; ld = 64; c0 = 0; }
      else { dst = p.vcmp; ld = 64; c0 = 0; }
#pragma unroll
      for (int mt = 0; mt < 4; ++mt)
#pragma unroll
        for (int i = 0; i < 16; ++i) {
          const size_t row = (size_t)m0 + wm * 128 + mt * 32 + (i & 3) + 8 * (i >> 2) + 4 * hh;
          dst[row * ld + c0 + r] = f2bf(acc[mt][0][i]);
          dst[row * ld + c0 + 32 + r] = f2bf(acc[mt][1][i]);
        }
    }
  }
}

constexpr int TP = 66;
DI void tr_load(const bfu* __restrict__ src, int pitch, bfu* T) {
  const int tid = TID();
#pragma unroll
  for (int j = 0; j < 4; ++j) {
    int c = tid + 256 * j; int tok = c >> 4, q = c & 15;
    u32x2 v = *(const u32x2*)(src + (size_t)tok * pitch + q * 4);
    *(unsigned*)(T + tok * TP + q * 4) = v[0];
    *(unsigned*)(T + tok * TP + q * 4 + 2) = v[1];
  }
}
DI void tr_store(const bfu* T, bfu* __restrict__ dst  ) {
  const int tid = TID();
#pragma unroll
  for (int j = 0; j < 2; ++j) {
    int c = tid + 256 * j; int d = c & 63, tc = c >> 6;
    bfu e[8];
#pragma unroll
    for (int q = 0; q < 8; ++q) e[q] = T[(tc * 8 + q) * TP + d];
    u32x4 o = {(unsigned)e[0] | ((unsigned)e[1] << 16), (unsigned)e[2] | ((unsigned)e[3] << 16), (unsigned)e[4] | ((unsigned)e[5] << 16), (unsigned)e[6] | ((unsigned)e[7] << 16)};
    *(u32x4*)(dst + (size_t)d * S + tc * 8) = o;
  }
}

DI void prep_item(const Params& p, int L, int item, char* smem) {
  const int tid = TID();
  const int b = item >> 5, s0 = (item & 31) * 64;
  const size_t t0 = (size_t)b * S + s0;
  const int sub = tid & 7;
#pragma unroll 1
  for (int jb = 0; jb < 44; jb += 4) {
    u32x2 v0[4], v1[4];
#pragma unroll
    for (int u = 0; u < 4; ++u) {
      const int job = (tid >> 3) + 32 * (jb + u);
      const int tok = job & 63, vec = job >> 6;
      int col;
      if (vec < 4) col = 64 * vec; else if (vec < 8) col = 256 + 64 * (vec - 4); else if (vec < 12) col = 1964 + 64 * (vec - 8);
      else if (vec < 16) col = 2220 + 64 * (vec - 12); else if (vec < 20) col = 1312 + 64 * (vec - 16); else if (vec == 20) col = 1696; else col = 1824;
      const bfu* src = p.proj + (t0 + tok) * PJ + col + sub * 8;
      v0[u] = *(const u32x2*)src; v1[u] = *(const u32x2*)(src + 4);
    }
#pragma unroll
    for (int u = 0; u < 4; ++u) {
      const int job = (tid >> 3) + 32 * (jb + u);
      const int tok = job & 63, vec = job >> 6;
      if ((vec < 8) ? (FUSE_MASK & 1) : (FUSE_MASK & 2)) continue;
      const float* g = nullptr; float sc = 1.f; bfu* dst;
      if (vec < 4)       { sc = 0.125f; dst = p.q_sb + (((size_t)(b * 4 + vec)) * S + s0 + tok) * 64; }
      else if (vec < 8)  { int h = vec - 4; dst = p.k_sb + (((size_t)(b * 4 + h)) * S + s0 + tok) * 64; }
      else if (vec < 12) { int h = vec - 8; g = p.fox_qn_g + L * 64; sc = 0.125f; dst = p.q_fox + (((size_t)(b * 4 + h)) * S + s0 + tok) * 64; }
      else if (vec < 16) { int h = vec - 12; g = p.fox_kn_g + L * 64; dst = p.k_fox + (((size_t)(b * 4 + h)) * S + s0 + tok) * 64; }
      else if (vec < 20) { int h = vec - 16; g = p.nsa_qn_g + L * 64; sc = 0.125f; dst = p.q_nsa + (((size_t)(b * 4 + h)) * S + s0 + tok) * 64; }
      else if (vec == 20) { g = p.nsa_kn_g + (L * 3 + 1) * 64; dst = p.ks + ((size_t)b * S + s0 + tok) * 64; }
      else               { g = p.nsa_kn_g + (L * 3 + 2) * 64; dst = p.kw + ((size_t)b * S + s0 + tok) * 64; }
      float e[8] = {bflo(v0[u][0]), bfhi(v0[u][0]), bflo(v0[u][1]), bfhi(v0[u][1]), bflo(v1[u][0]), bfhi(v1[u][0]), bflo(v1[u][1]), bfhi(v1[u][1])};
      float ss = 0.f;
#pragma unroll
      for (int q = 0; q < 8; ++q) ss += e[q] * e[q];
      ss += __shfl_xor(ss, 1); ss += __shfl_xor(ss, 2); ss += __shfl_xor(ss, 4);
      const float rs = g ? rsqrtf(ss * (1.f / 64.f) + EPS) * sc : sc;
#pragma unroll
      for (int q = 0; q < 8; ++q) e[q] = e[q] * rs * (g ? g[sub * 8 + q] : 1.f);
      *(u32x4*)(dst + sub * 8) = (u32x4){pk2(e[0], e[1]), pk2(e[2], e[3]), pk2(e[4], e[5]), pk2(e[6], e[7])};
    }
  }
  if (!(FUSE_MASK & 8)) {
    const int tok = tid >> 2, sub = tid & 3;
    *(u32x4*)(p.krope + (t0 + tok) * 32 + sub * 8) = *(const u32x4*)(p.proj + (t0 + tok) * PJ + 1280 + sub * 8);
  }
  bfu* T = (bfu*)smem;
  if (!(FUSE_MASK & 4))
  for (int grp = 0; grp < 2; ++grp) {
    __syncthreads();
#pragma unroll 1
    for (int q = 0; q < 5; ++q) {
      int v = grp * 5 + q; int col;
      if (v < 4) col = 512 + 64 * v; else if (v < 8) col = 2476 + 64 * (v - 4); else if (v == 8) col = 1760; else col = 1888;
      tr_load(p.proj + t0 * PJ + col, PJ, T + q * 64 * TP);
    }
    __syncthreads();
#pragma unroll 1
    for (int q = 0; q < 5; ++q) {
      int v = grp * 5 + q; bfu* dst;
      if (v < 4) dst = p.vt_sb + ((size_t)(b * 4 + v) * 64) * S + s0;
      else if (v < 8) dst = p.vt_fox + ((size_t)(b * 4 + (v - 4)) * 64) * S + s0;
      else if (v == 8) dst = p.vts + ((size_t)b * 64) * S + s0;
      else dst = p.vtw + ((size_t)b * 64) * S + s0;
      tr_store(T + q * 64 * TP, dst);
    }
  }
}

DI void compress_item(const Params& p, int L, int item, char* smem) {
  GEMM_IDS
  const int b = item >> 1, kv = item & 1;
  const int m0 = 0, n0 = 0;
  f32x16 acc[2][2]; ZERO_ACC(acc)
  gemm_core<false>((kv ? p.vcmp : p.kcmp) + (size_t)b * S * 64, 1024, p.wt_w1 + (size_t)kv * 128 * 2048, 2048, 2048, 0, 0, acc, smem);
  float* Hs = (float*)smem;
  float* W2 = (float*)(smem + 128 * 65 * 4);
  const float* w2 = (kv ? p.nsa_w2_v : p.nsa_w2_k) + (size_t)L * 64 * 64;
  for (int e = tid; e < 1024; e += 256) *(float4*)(W2 + e * 4) = *(const float4*)(w2 + e * 4);
  if (wn == 0) {
#pragma unroll
    for (int mt = 0; mt < 2; ++mt)
#pragma unroll
      for (int nt = 0; nt < 2; ++nt)
#pragma unroll
        for (int i = 0; i < 16; ++i) {
          const int rl = wm * 64 + mt * 32 + (i & 3) + 8 * (i >> 2) + 4 * hh;
          const int n = nt * 32 + r;
          float pb_ = 0.f;
#pragma unroll
          for (int q8 = 0; q8 < 8; ++q8) pb_ += p.pebias[(kv * 8 + q8) * 64 + n];
          const float hsum = acc[mt][nt][i] + pb_;
          Hs[rl * 65 + n] = hsum / (1.f + __expf(-hsum));
        }
  }
  (void)m0; (void)n0;
  __syncthreads();
  const int row = tid >> 1, nh = tid & 1;
  float o[32];
#pragma unroll
  for (int j = 0; j < 32; ++j) o[j] = 0.f;
  for (int k = 0; k < 64; ++k) {
    const float hk = Hs[row * 65 + k];
    const float* wr = W2 + k * 64 + nh * 32;
#pragma unroll
    for (int j = 0; j < 32; j += 4) { float4 w4 = *(const float4*)(wr + j); o[j] += hk * w4.x; o[j + 1] += hk * w4.y; o[j + 2] += hk * w4.z; o[j + 3] += hk * w4.w; }
  }
  if (kv == 0) {
    float ss = 0.f;
#pragma unroll
    for (int j = 0; j < 32; ++j) ss += o[j] * o[j];
    ss += __shfl_xor(ss, 1);
    const float rs = rsqrtf(ss * (1.f / 64.f) + EPS);
    const float* g = p.nsa_kn_g + (L * 3 + 0) * 64 + nh * 32;
#pragma unroll
    for (int j = 0; j < 32; ++j) o[j] = o[j] * rs * g[j];
  }
  if (row == 127) {
#pragma unroll
    for (int j = 0; j < 32; ++j) o[j] = 0.f;
  }
  if (kv == 0) {
    bfu* dst = p.kc_b + ((size_t)b * 128 + row) * 64 + nh * 32;
#pragma unroll
    for (int j = 0; j < 32; j += 8) *(u32x4*)(dst + j) = (u32x4){pk2(o[j], o[j + 1]), pk2(o[j + 2], o[j + 3]), pk2(o[j + 4], o[j + 5]), pk2(o[j + 6], o[j + 7])};
  } else {
    bfu* dst = p.vct_b + ((size_t)b * 64 + nh * 32) * 128 + row;
#pragma unroll
    for (int j = 0; j < 32; ++j) dst[(size_t)j * 128] = f2bf(o[j]);
  }
  __syncthreads();
}

DI void foxcum_item(const Params& p, int L, int item) {
  const int tid = TID(), lane = tid & 63, w = tid >> 6;
  const int job = item * 4 + w;
  const int b = job >> 2, h = job & 3;
  const float fb = p.fox_f_bias[L * 4 + h];
  float v[32]; float run = 0.f;
#pragma unroll
  for (int q = 0; q < 32; ++q) {
    float z = p.small_[((size_t)b * S + lane * 32 + q) * 16 + 12 + h] + fb;
    float ls = fminf(z, 0.f) - __logf(1.f + __expf(-fabsf(z)));
    run += ls; v[q] = run;
  }
  float inc = run;
#pragma unroll
  for (int q = 1; q < 64; q <<= 1) { float t = __shfl_up(inc, q); if (lane >= q) inc += t; }
  float excl = inc - run;
#pragma unroll
  for (int q = 0; q < 32; ++q) p.cum[((size_t)(b * 4 + h)) * S + lane * 32 + q] = v[q] + excl;
}

DI void phase_prep(const Params& p, int L, char* smem) {
  GEMM_IDS
  const int N_CMP = 16, N_PREP = (FUSE_MASK & 15) == 15 ? 0 : 256, N_G2 = 128 * 3, N_G3 = 128 * 4, N_FC = 8;
  const int o1 = N_CMP, o2 = o1 + N_FC, o3 = o2 + N_PREP, o4 = o3 + N_G2, o5 = o4 + N_G3;
  for (int it = blockIdx.x; it < o5; it += gridDim.x) {
    if (it < o1) compress_item(p, L, it, smem);
    else if (it < o2) foxcum_item(p, L, it - o1);
    else if (it < o3) prep_item(p, L, it - o2, smem);
    else if (it < o4) {
      const int t = it - o3; const int m0 = (t / 3) * 128, n0 = (t % 3) * 128;
      f32x16 acc[2][2]; ZERO_ACC(acc)
      if (FUSE_MASK & 8) gemm_core<true>(p.cq, 384, p.wt_uq, 384, 384, m0, n0, acc, smem);
      else gemm_core<true>(p.proj + 768, PJ, p.wt_uq, 384, 384, m0, n0, acc, smem);
      EPI_BEGIN(acc) p.qraw[(size_t)row * 384 + col] = f2bf(v * rstd_s[rl]); EPI_END
    } else {
      const int t = it - o4; const int m0 = (t >> 2) * 128, n0 = (t & 3) * 128;
      f32x16 acc[2][2]; ZERO_ACC(acc)
      if (FUSE_MASK & 8) gemm_core<true>(p.ckv, 128, p.wt_ukv, 128, 128, m0, n0, acc, smem);
      else gemm_core<true>(p.proj + 1152, PJ, p.wt_ukv, 128, 128, m0, n0, acc, smem);
      EPI_BEGIN(acc) p.kvraw[(size_t)row * 512 + col] = f2bf(v * rstd_s[rl]); EPI_END
    }
  }
}

DI void mlaprep_item(const Params& p, int L, int item, char* smem) {
  const int tid = TID();
  const int b = item >> 5, s0 = (item & 31) * 64;
  const int tok = tid >> 2, h = tid & 3;
  const int spos = s0 + tok;
  const size_t t = (size_t)b * S + spos;
#pragma unroll 1
  for (int which = 0; which < 2; ++which) {
    const bfu* srcA = which ? (p.kvraw + t * 512 + h * 128) : (p.qraw + t * 384 + h * 96);
    const bfu* srcB = which ? (p.krope + t * 32) : (p.qraw + t * 384 + h * 96 + 64);
    const float* g = (which ? p.mla_kn_g : p.mla_qn_g) + L * 96;
    float ss = 0.f;
#pragma unroll
    for (int c = 0; c < 12; ++c) {
      u32x4 v = *(const u32x4*)((c < 8) ? (srcA + c * 8) : (srcB + (c - 8) * 8));
#pragma unroll
      for (int q = 0; q < 4; ++q) { float lo = bflo(v[q]), hi = bfhi(v[q]); ss += lo * lo + hi * hi; }
    }
    const float sc = which ? 1.f : 0.10206207261596577f;
    const float rs = rsqrtf(ss * (1.f / 96.f) + EPS) * sc;
    bfu* dst = (which ? p.k_mla : p.q_mla) + (((size_t)(b * 4 + h)) * S + spos) * 96;
#pragma unroll
    for (int c = 0; c < 8; ++c) {
      u32x4 v = *(const u32x4*)(srcA + c * 8);
      const float* gc = g + c * 8;
      *(u32x4*)(dst + c * 8) = (u32x4){pk2(bflo(v[0]) * rs * gc[0], bfhi(v[0]) * rs * gc[1]), pk2(bflo(v[1]) * rs * gc[2], bfhi(v[1]) * rs * gc[3]),
                                       pk2(bflo(v[2]) * rs * gc[4], bfhi(v[2]) * rs * gc[5]), pk2(bflo(v[3]) * rs * gc[6], bfhi(v[3]) * rs * gc[7])};
    }
#pragma unroll
    for (int c = 0; c < 2; ++c) {
      u32x4 va = *(const u32x4*)(srcB + c * 8);
      u32x4 vb = *(const u32x4*)(srcB + 16 + c * 8);
      float oa[8], ob[8];
#pragma unroll
      for (int q = 0; q < 8; ++q) {
        const int i2 = c * 8 + q;
        float a = ((q & 1) ? bfhi(va[q >> 1]) : bflo(va[q >> 1])) * rs * g[64 + i2];
        float bb = ((q & 1) ? bfhi(vb[q >> 1]) : bflo(vb[q >> 1])) * rs * g[80 + i2];
        float inv = expf(-9.210340371976184f * (float)i2 / 16.f);
        float ang = (float)spos * inv;
        double rv = (double)ang * 0.15915494309189535; rv -= floor(rv);
        float fr = (float)rv;
        float cs = __builtin_amdgcn_cosf(fr), sn = __builtin_amdgcn_sinf(fr);
        oa[q] = a * cs - bb * sn; ob[q] = bb * cs + a * sn;
      }
      *(u32x4*)(dst + 64 + c * 8) = (u32x4){pk2(oa[0], oa[1]), pk2(oa[2], oa[3]), pk2(oa[4], oa[5]), pk2(oa[6], oa[7])};
      *(u32x4*)(dst + 80 + c * 8) = (u32x4){pk2(ob[0], ob[1]), pk2(ob[2], ob[3]), pk2(ob[4], ob[5]), pk2(ob[6], ob[7])};
    }
  }
  bfu* T = (bfu*)smem;
  __syncthreads();
#pragma unroll 1
  for (int q = 0; q < 4; ++q) tr_load(p.kvraw + ((size_t)b * S + s0) * 512 + q * 128 + 64, 512, T + q * 64 * TP);
  __syncthreads();
#pragma unroll 1
  for (int q = 0; q < 4; ++q) tr_store(T + q * 64 * TP, p.vt_mla + ((size_t)(b * 4 + q) * 64) * S + s0);
}

DI int rel_bucket_dev(int d) {
  if (d < 16) return d;
  int v = 16 + (int)(logf((float)d / 16.f) / 2.0794415416798357f * 16.f);
  return v < 31 ? v : 31;
}

DI void nsacmp_item(const Params& p, int L, int item, char* smem) {
  (void)L;
  const int tid = TID(), lane = tid & 63, w = __builtin_amdgcn_readfirstlane(tid >> 6), r = lane & 31, hh = lane >> 5;
  const int b = item >> 6, s0 = (item & 63) * 32;
  constexpr int CKP = 72, CVP = 136;
  bfu* Ks = (bfu*)smem;
  bfu* Vt = (bfu*)(smem + 18432);
  float* lut = (float*)(smem + 35840);
  float* impx = (float*)(smem + 37952);
  const int tmax = s0 + 31;
  const int ncv_max = tmax >= 31 ? (tmax - 31) / 16 + 1 : 0;
  const int nct = (ncv_max + 31) >> 5;
  __syncthreads();
#pragma unroll
  for (int j = 0; j < 4; ++j) {
    const int c = tid + 256 * j;
    const int row = c >> 3, kc8 = c & 7;
    *(u32x4*)(Ks + row * CKP + kc8 * 8) = *(const u32x4*)(p.kc_b + ((size_t)b * 128 + row) * 64 + kc8 * 8);
    const int d = c >> 4, cc = c & 15;
    *(u32x4*)(Vt + d * CVP + cc * 8) = *(const u32x4*)(p.vct_b + ((size_t)b * 64 + d) * 128 + cc * 8);
  }
  for (int e = tid; e < 4 * 129; e += 256) { int hq = e / 129, d = e % 129; lut[hq * 132 + d] = p.rel_bias[rel_bucket_dev(d) * 4 + hq]; }
  __syncthreads();
  const int h = w;
  const int spos = s0 + r;
  const size_t t = (size_t)b * S + spos;
  bf16x8 qf[4];
#pragma unroll
  for (int ks = 0; ks < 4; ++ks) qf[ks] = *(const bf16x8*)(p.q_nsa + (((size_t)(b * 4 + h)) * S + spos) * 64 + ks * 16 + hh * 8);
  f32x16 sc[4];
#pragma unroll
  for (int ct = 0; ct < 4; ++ct) {
#pragma unroll
    for (int i = 0; i < 16; ++i) sc[ct][i] = 0.f;
    if (ct < nct) {
#pragma unroll
      for (int ks = 0; ks < 4; ++ks) {
        bf16x8 a = *(const bf16x8*)(Ks + (32 * ct + r) * CKP + ks * 16 + hh * 8);
        sc[ct] = MFMA(a, qf[ks], sc[ct]);
      }
    }
  }
  const int ncv = spos >= 31 ? (spos - 31) / 16 + 1 : 0;
  const float* lutl = lut + h * 132;
  float mx = -INFINITY;
#pragma unroll
  for (int ct = 0; ct < 4; ++ct)
#pragma unroll
    for (int i = 0; i < 16; ++i) {
      const int c = 32 * ct + (i & 3) + 8 * (i >> 2) + 4 * hh;
      int dd = spos - 16 * c - 31; dd = dd < 0 ? 0 : (dd > 128 ? 128 : dd);
      const float sv = (c < ncv) ? (sc[ct][i] + lutl[dd]) : -INFINITY;
      sc[ct][i] = sv; mx = fmaxf(mx, sv);
    }
  mx = fmaxf(mx, __shfl_xor(mx, 32));
  const float m_use = (mx == -INFINITY) ? 0.f : mx;
  float l = 0.f;
#pragma unroll
  for (int ct = 0; ct < 4; ++ct)
#pragma unroll
    for (int i = 0; i < 16; ++i) { const float pv = __expf(sc[ct][i] - m_use); sc[ct][i] = pv; l += pv; }
  l += __shfl_xor(l, 32);
  const float il = (l > 0.f) ? 1.f / l : 0.f;
#pragma unroll
  for (int ct = 0; ct < 4; ++ct)
#pragma unroll
    for (int i = 0; i < 16; ++i) sc[ct][i] *= il;
  {
    float* imr = impx + (h * 32 + r) * 33;
    float prev = 0.f;
#pragma unroll
    for (int ct = 0; ct < 4; ++ct)
#pragma unroll
      for (int g = 0; g < 4; ++g) {
        const float G = (sc[ct][4 * g] + sc[ct][4 * g + 1]) + (sc[ct][4 * g + 2] + sc[ct][4 * g + 3]);
        const float rcv = __shfl_xor(sc[ct][4 * g + 3], 32);
        const float extra = hh ? rcv : prev;
        imr[8 * ct + 2 * g + hh] = G + extra;
        prev = rcv;
      }
  }
  f32x16 o[2];
#pragma unroll
  for (int dt = 0; dt < 2; ++dt)
#pragma unroll
    for (int i = 0; i < 16; ++i) o[dt][i] = 0.f;
#pragma unroll
  for (int ct = 0; ct < 4; ++ct) {
    if (ct < nct) {
#pragma unroll
      for (int s2 = 0; s2 < 2; ++s2) {
        bf16x8 pf = PACK8(sc[ct], 8 * s2);
#pragma unroll
        for (int dt = 0; dt < 2; ++dt) {
          const bfu* vp = Vt + (32 * dt + r) * CVP + 32 * ct + 16 * s2 + 4 * hh;
          s16x4 lo4 = *(const s16x4*)vp;
          s16x4 hi4 = *(const s16x4*)(vp + 8);
          bf16x8 a = __builtin_shufflevector(lo4, hi4, 0, 1, 2, 3, 4, 5, 6, 7);
          o[dt] = MFMA(a, pf, o[dt]);
        }
      }
    }
  }
  {
    const float g0 = sigmoidf_(p.small_[t * 16 + 0 * 4 + h]);
    float* dst = p.ocmp + (t * 4 + h) * 64;
#pragma unroll
    for (int dt = 0; dt < 2; ++dt)
#pragma unroll
      for (int g = 0; g < 4; ++g)
        *(float4*)(dst + 32 * dt + 8 * g + 4 * hh) = make_float4(o[dt][4 * g] * g0, o[dt][4 * g + 1] * g0, o[dt][4 * g + 2] * g0, o[dt][4 * g + 3] * g0);
  }
  __syncthreads();
  {
    const int tk = tid >> 3, sub = tid & 7;
    float* i0 = impx + tk * 33;
#pragma unroll
    for (int q = 0; q < 4; ++q) {
      const int j = sub * 4 + q;
      i0[j] = (i0[j] + impx[(32 + tk) * 33 + j]) + (impx[(64 + tk) * 33 + j] + impx[(96 + tk) * 33 + j]);
    }
    __syncthreads();
    const int sp = s0 + tk;
    const int cur = sp >> 6;
    unsigned mask = 0;
#pragma unroll 1
    for (int q = 0; q < 4; ++q) {
      const int j = sub * 4 + q;
      if (j <= cur) {
        const bool fj = (j == 0) || (j == cur) || (j == cur - 1);
        const float vj = fj ? 1e9f : i0[j];
        int rank = 0;
        for (int i2 = 0; i2 <= cur; ++i2) {
          const bool fi = (i2 == 0) || (i2 == cur) || (i2 == cur - 1);
          const float vi = fi ? 1e9f : i0[i2];
          rank += (vi > vj || (vi == vj && i2 < j)) ? 1 : 0;
        }
        if (rank < 16) mask |= (1u << j);
      }
    }
    mask |= __shfl_xor(mask, 1); mask |= __shfl_xor(mask, 2); mask |= __shfl_xor(mask, 4);
    if (sub == 0) p.selmask[(size_t)b * S + sp] = mask;
  }
}

constexpr int VP = 72;
constexpr int AT_KS = 0, AT_VS = 13312, AT_CUM = 22528, AT_FLAGS = 22784, AT_OR = 22800, AT_LUT = 22816;

template <int MODE>
DI void attn_run(const bfu* __restrict__ Qp, const bfu* __restrict__ Kp, const bfu* __restrict__ Vtp, int qt,
                 f32x16 (&o)[2], const float* __restrict__ cump, unsigned sel, unsigned blockmask, char* smem) {
  constexpr int DK = (MODE == 1) ? 96 : 64;
  constexpr int KP = DK + 8;
  constexpr int NKS = DK / 16;
  constexpr int KCH = DK / 8;
  constexpr int NKC = 64 * KCH / 256;
  bfu* Ks = (bfu*)(smem + AT_KS);
  bfu* Vs = (bfu*)(smem + AT_VS);
  float* cumk = (float*)(smem + AT_CUM);
  int* flags = (int*)(smem + AT_FLAGS);
  const float* lut = (const float*)(smem + AT_LUT);
  const int tid = TID(), lane = tid & 63, w = tid >> 6, r = lane & 31, hh = lane >> 5;
  const int q0 = qt * 128;
  const int t = q0 + w * 32 + r;
  const int tw_min = q0 + w * 32, tw_max = tw_min + 31;
  bf16x8 qf[NKS];
#pragma unroll
  for (int ks = 0; ks < NKS; ++ks) qf[ks] = *(const bf16x8*)(Qp + (size_t)t * DK + ks * 16 + hh * 8);
  float cumq = 0.f;
  if (MODE == 2) cumq = cump[t];
  bf16x8 U[2];
  if (MODE == 0) {
#pragma unroll
    for (int s2 = 0; s2 < 2; ++s2)
#pragma unroll
      for (int j = 0; j < 8; ++j) { int kk = 16 * s2 + 8 * (j >> 2) + 4 * hh + (j & 3); U[s2][j] = (kk > r) ? (short)0x3F80 : (short)0; }
  }
#pragma unroll
  for (int dt = 0; dt < 2; ++dt)
#pragma unroll
    for (int i = 0; i < 16; ++i) o[dt][i] = 0.f;
  float m = -INFINITY, l = 0.f, carry = 0.f;

  int kt_lo = 0, kt_hi = 2 * qt + 1;
  if (MODE == 4) kt_lo = (2 * qt - 8) > 0 ? (2 * qt - 8) : 0;
  int kt;
  if (MODE == 0) kt = kt_hi;
  else if (MODE == 3) { kt = kt_lo; while (kt <= kt_hi && !((blockmask >> kt) & 1u)) ++kt; }
  else kt = kt_lo;
  u32x4 rk[NKC], rv[2]; float rc = 0.f;
#define ATT_LOAD(KT)                                                                                              \
  { const int k0_ = (KT) * 64;                                                                                    \
    _Pragma("unroll") for (int j = 0; j < NKC; ++j) { int c = tid + 256 * j; int row = c / KCH, kc = c % KCH;       \
      rk[j] = *(const u32x4*)(Kp + (size_t)(k0_ + row) * DK + kc * 8); }                                           \
    _Pragma("unroll") for (int j = 0; j < 2; ++j) { int c = tid + 256 * j; int d = c >> 3, kc = c & 7;              \
      rv[j] = *(const u32x4*)(Vtp + (size_t)d * S + k0_ + kc * 8); }                                               \
    if (MODE == 2) { if (tid < 64) rc = cump[k0_ + tid]; } }
  if (kt <= kt_hi && kt >= 0) { ATT_LOAD(kt) }
  while (kt >= kt_lo && kt <= kt_hi) {
    BAR_LDS();
    if (MODE == 0) { if (flags[0] && flags[1] && flags[2] && flags[3]) break; }
#pragma unroll
    for (int j = 0; j < NKC; ++j) { int c = tid + 256 * j; int row = c / KCH, kc = c % KCH; *(u32x4*)(Ks + row * KP + kc * 8) = rk[j]; }
#pragma unroll
    for (int j = 0; j < 2; ++j) { int c = tid + 256 * j; int d = c >> 3, kc = c & 7; *(u32x4*)(Vs + d * VP + kc * 8) = rv[j]; }
    if (MODE == 2) { if (tid < 64) cumk[tid] = rc; }
    BAR_LDS();
    int nkt;
    if (MODE == 0) nkt = kt - 1;
    else if (MODE == 3) { nkt = kt + 1; while (nkt <= kt_hi && !((blockmask >> nkt) & 1u)) ++nkt; }
    else nkt = kt + 1;
    { const int lk_ = (nkt >= kt_lo && nkt <= kt_hi) ? nkt : kt;
      ATT_LOAD(lk_) }
    const int k0 = kt * 64;
    bool active;
    if (MODE == 0) active = (k0 < tw_max);
    else if (MODE == 4) active = (k0 <= tw_max) && (k0 + 63 >= tw_min - 511);
    else active = (k0 <= tw_max);
    if (active) {
      f32x16 sc[2];
#pragma unroll
      for (int mt = 0; mt < 2; ++mt) {
#pragma unroll
        for (int i = 0; i < 16; ++i) sc[mt][i] = 0.f;
#pragma unroll
        for (int ks = 0; ks < NKS; ++ks) {
          bf16x8 a = *(const bf16x8*)(Ks + (32 * mt + r) * KP + ks * 16 + hh * 8);
          sc[mt] = MFMA(a, qf[ks], sc[mt]);
        }
      }
      if (MODE == 0) {
        f32x16 Lm[2]; float cs[2];
#pragma unroll
        for (int mt = 0; mt < 2; ++mt) {
          float c_ = 0.f;
#pragma unroll
          for (int i = 0; i < 16; ++i) {
            const int key = k0 + 32 * mt + (i & 3) + 8 * (i >> 2) + 4 * hh;
            const float z = sc[mt][i];
            const bool past = key < t;
            const float sp = fmaxf(z, 0.f) + __logf(1.f + __expf(-fabsf(z)));
            const float Lv = past ? -sp : 0.f;
            Lm[mt][i] = Lv; c_ += Lv;
            sc[mt][i] = past ? (z - sp) : -INFINITY;
          }
          c_ += __shfl_xor(c_, 32);
          cs[mt] = c_;
        }
#pragma unroll
        for (int mt = 0; mt < 2; ++mt) {
          f32x16 bt;
#pragma unroll
          for (int i = 0; i < 16; ++i) bt[i] = 0.f;
#pragma unroll
          for (int s2 = 0; s2 < 2; ++s2) {
            float lo8[8]; unsigned hb[8];
#pragma unroll
            for (int j = 0; j < 8; ++j) { float Lv = Lm[mt][8 * s2 + j]; bfu hbits = f2bf(Lv); hb[j] = hbits; lo8[j] = Lv - bf2f(hbits); }
            bf16x8 hi = __builtin_bit_cast(bf16x8, (u32x4){hb[0] | (hb[1] << 16), hb[2] | (hb[3] << 16), hb[4] | (hb[5] << 16), hb[6] | (hb[7] << 16)});
            bf16x8 lo = __builtin_bit_cast(bf16x8, (u32x4){pk2(lo8[0], lo8[1]), pk2(lo8[2], lo8[3]), pk2(lo8[4], lo8[5]), pk2(lo8[6], lo8[7])});
            bt = MFMA(U[s2], hi, bt);
            bt = MFMA(U[s2], lo, bt);
          }
          const float add = carry + (mt == 0 ? cs[1] : 0.f);
#pragma unroll
          for (int i = 0; i < 16; ++i) sc[mt][i] = __expf(sc[mt][i] + bt[i] + add);
        }
        carry += cs[0] + cs[1];
      } else {
        float mxv = -INFINITY;
        const bool need_mask = (MODE == 3) || (k0 + 63 > tw_min) || (MODE == 4 && (k0 < tw_max - 511));
        if (need_mask) {
#pragma unroll
          for (int mt = 0; mt < 2; ++mt)
#pragma unroll
            for (int i = 0; i < 16; ++i) {
              const int kl = 32 * mt + (i & 3) + 8 * (i >> 2) + 4 * hh;
              const int key = k0 + kl;
              float s = sc[mt][i];
              bool valid;
              if (MODE == 1) valid = key <= t;
              else if (MODE == 2) { valid = key <= t; s += cumq - cumk[kl]; }
              else {
                int dd = t - key;
                if (MODE == 3) valid = (dd >= 0) && ((sel >> kt) & 1u); else valid = (dd >= 0) && (dd < 512);
                int di = dd < 0 ? 0 : (dd > 128 ? 128 : dd);
                s += lut[di];
              }
              s = valid ? s : -INFINITY;
              sc[mt][i] = s; mxv = fmaxf(mxv, s);
            }
        } else {
#pragma unroll
          for (int mt = 0; mt < 2; ++mt)
#pragma unroll
            for (int i = 0; i < 16; ++i) {
              const int kl = 32 * mt + (i & 3) + 8 * (i >> 2) + 4 * hh;
              float s = sc[mt][i];
              if (MODE == 2) s += cumq - cumk[kl];
              if (MODE == 4) { int dd = t - (k0 + kl); s += lut[dd > 128 ? 128 : dd]; }
              sc[mt][i] = s; mxv = fmaxf(mxv, s);
            }
        }
        mxv = fmaxf(mxv, __shfl_xor(mxv, 32));
        const float m_new = fmaxf(m, mxv);
        const float m_use = (m_new == -INFINITY) ? 0.f : m_new;
        if (__any(m_new != m)) {
          const float alpha = __expf(m - m_use);
          l *= alpha;
#pragma unroll
          for (int dt = 0; dt < 2; ++dt)
#pragma unroll
            for (int i = 0; i < 16; ++i) o[dt][i] *= alpha;
        }
        const float mL = m_use * 1.4426950408889634f;
        float ps = 0.f;
#pragma unroll
        for (int mt = 0; mt < 2; ++mt)
#pragma unroll
          for (int i = 0; i < 16; ++i) { float pv = __builtin_amdgcn_exp2f(__builtin_fmaf(sc[mt][i], 1.4426950408889634f, -mL)); ps += pv; sc[mt][i] = pv; }
        l += ps; m = m_new;
      }
#pragma unroll
      for (int mt = 0; mt < 2; ++mt)
#pragma unroll
        for (int s2 = 0; s2 < 2; ++s2) {
          bf16x8 pf = PACK8(sc[mt], 8 * s2);
#pragma unroll
          for (int dt = 0; dt < 2; ++dt) {
            const bfu* vp = Vs + (32 * dt + r) * VP + 32 * mt + 16 * s2 + 4 * hh;
            s16x4 lo4 = *(const s16x4*)vp;
            s16x4 hi4 = *(const s16x4*)(vp + 8);
            bf16x8 a = __builtin_shufflevector(lo4, hi4, 0, 1, 2, 3, 4, 5, 6, 7);
            o[dt] = MFMA(a, pf, o[dt]);
          }
        }
    }
    if (MODE == 0) { int dn = __all(carry < -110.f) ? 1 : 0; if (lane == 0) flags[w] = dn; }
    kt = nkt;
  }
#undef ATT_LOAD
  if (MODE != 0) {
    l += __shfl_xor(l, 32);
    const float il = 1.f / l;
#pragma unroll
    for (int dt = 0; dt < 2; ++dt)
#pragma unroll
      for (int i = 0; i < 16; ++i) o[dt][i] *= il;
  }
}

DI void attn_store(bfu* __restrict__ yrow  , const f32x16 (&o)[2], int hh) {
#pragma unroll
  for (int dt = 0; dt < 2; ++dt)
#pragma unroll
    for (int g = 0; g < 4; ++g) {
      u32x2 v = {pk2(o[dt][4 * g], o[dt][4 * g + 1]), pk2(o[dt][4 * g + 2], o[dt][4 * g + 3])};
      *(u32x2*)(yrow + 32 * dt + 8 * g + 4 * hh) = v;
    }
}

template <int MODE>
DI void attn_item(const Params& p, int idx, char* smem) {
  const int tid = TID(), lane = tid & 63, w = tid >> 6, r = lane & 31, hh = lane >> 5;
  const int qt = 15 - (idx >> 5); const int bh = idx & 31, b = bh >> 2, h = bh & 3;
  const int spos = qt * 128 + w * 32 + r;
  const size_t t = (size_t)b * S + spos;
  __syncthreads();
  if (tid < 4) ((int*)(smem + AT_FLAGS))[tid] = 0;
  f32x16 o[2];
  if (MODE == 0) {
    attn_run<0>(p.q_sb + (size_t)bh * S * 64, p.k_sb + (size_t)bh * S * 64, p.vt_sb + (size_t)bh * 64 * S, qt, o, nullptr, 0u, 0u, smem);
    attn_store(p.y + t * 1024 + 0 * 256 + h * 64, o, hh);
  } else if (MODE == 1) {
    attn_run<1>(p.q_mla + (size_t)bh * S * 96, p.k_mla + (size_t)bh * S * 96, p.vt_mla + (size_t)bh * 64 * S, qt, o, nullptr, 0u, 0u, smem);
    attn_store(p.y + t * 1024 + 1 * 256 + h * 64, o, hh);
  } else if (MODE == 2) {
    attn_run<2>(p.q_fox + (size_t)bh * S * 64, p.k_fox + (size_t)bh * S * 64, p.vt_fox + (size_t)bh * 64 * S, qt, o, p.cum + (size_t)bh * S, 0u, 0u, smem);
    attn_store(p.y + t * 1024 + 3 * 256 + h * 64, o, hh);
  } else {
    float* lut = (float*)(smem + AT_LUT);
    unsigned* sor = (unsigned*)(smem + AT_OR);
    if (tid == 0) *sor = 0u;
    if (tid < 129) lut[tid] = p.rel_bias[rel_bucket_dev(tid) * 4 + h];
    __syncthreads();
    const unsigned sel = p.selmask[t];
    atomicOr(sor, sel);
    __syncthreads();
    const unsigned bm = *sor;
    attn_run<3>(p.q_nsa + (size_t)bh * S * 64, p.ks + (size_t)b * S * 64, p.vts + (size_t)b * 64 * S, qt, o, nullptr, sel, bm, smem);
    const float g1 = sigmoidf_(p.small_[t * 16 + 4 + h]);
    const float g2 = sigmoidf_(p.small_[t * 16 + 8 + h]);
    f32x16 tot[2];
    const float* oc = p.ocmp + (t * 4 + h) * 64;
#pragma unroll
    for (int dt = 0; dt < 2; ++dt)
#pragma unroll
      for (int g = 0; g < 4; ++g) {
        float4 c4 = *(const float4*)(oc + 32 * dt + 8 * g + 4 * hh);
        tot[dt][4 * g] = c4.x + g1 * o[dt][4 * g]; tot[dt][4 * g + 1] = c4.y + g1 * o[dt][4 * g + 1];
        tot[dt][4 * g + 2] = c4.z + g1 * o[dt][4 * g + 2]; tot[dt][4 * g + 3] = c4.w + g1 * o[dt][4 * g + 3];
      }
    attn_run<4>(p.q_nsa + (size_t)bh * S * 64, p.kw + (size_t)b * S * 64, p.vtw + (size_t)b * 64 * S, qt, o, nullptr, 0u, 0u, smem);
#pragma unroll
    for (int dt = 0; dt < 2; ++dt)
#pragma unroll
      for (int i = 0; i < 16; ++i) tot[dt][i] += g2 * o[dt][i];
    attn_store(p.y + t * 1024 + 2 * 256 + h * 64, tot, hh);
  }
}

DI void phase_attn1(const Params& p, int L, char* smem) {
  const int extra = (L > 0) ? CV_NC : 0;
  for (int it = blockIdx.x; it < 1792 + extra; it += gridDim.x) {
    if (it < 512) attn_item<2>(p, it, smem);
    else if (it < 1024) nsacmp_item(p, L, it - 512, smem);
    else if (it < 1536) attn_item<0>(p, it - 1024, smem);
    else if (it < 1792) mlaprep_item(p, L, it - 1536, smem);
    else conv_item_C(p, L, it - 1792, smem);
  }
}
DI void phase_attn2(const Params& p, char* smem) {
  for (int it = blockIdx.x; it < 1024; it += gridDim.x) {
    const int j = (it & 511) >> 1;
    const int idx = (it < 512) ? j : (511 - j);
    if (it & 1) attn_item<1>(p, idx, smem); else attn_item<3>(p, idx, smem);
  }
}

DI void phase_widen(const Params& p, char* smem) {
  GEMM_IDS
  for (int id = blockIdx.x; id < 128 * 8; id += gridDim.x) {
    int tm, tn; map_tile(id, 8, tm, tn);
    const int m0 = tm * 128, n0 = tn * 128;
    f32x16 tot[2][2]; ZERO_ACC(tot)
    f32x16 acc[2][2]; ZERO_ACC(acc)
    auto flush = [&](int n) {
      EPI_BEGIN(acc) tot[mt][nt][i] += v * bf2f(p.gates[(size_t)row * 4096 + n * 1024 + col]); acc[mt][nt][i] = 0.f; EPI_END
    };
    gemm_core_h<false, false, 2, 4>(p.y, 1024, p.wt_br, 1024, 1024, m0, n0, acc, smem, flush);
    EPI_BEGIN(tot) p.u[(size_t)row * 1024 + col] = f2bf(v); EPI_END
  }
}
DI void phase_resid(const Params& p, const bfu* A, int lda, const bfu* Bt, int K, char* smem) {
  GEMM_IDS
  for (int id = blockIdx.x; id < 64 * 8; id += gridDim.x) {
    int tm, tn; map_tile(id, 8, tm, tn);
    const int m0 = tm * 256, n0 = tn * 128;
    f32x16 acc[4][2]; ZERO_ACCM(acc, 4)
    gemm_core<false, false, 4>(A, lda, Bt, K, K, m0, n0, acc, smem);
    EPI_BEGINM(acc, 4)
      float* xp = p.out + (size_t)row * 1024 + col;
      float nv = *xp + v; *xp = nv; p.xb[(size_t)row * 1024 + col] = f2bf(nv);
    EPI_END
  }
}
DI void phase_up(const Params& p, char* smem) {
  GEMM_IDS
  for (int id = blockIdx.x; id < 64 * 32; id += gridDim.x) {
    int tm, tn; map_tile(id, 32, tm, tn);
    const int m0 = tm * 256, n0 = tn * 128;
    f32x16 acc[4][2]; ZERO_ACCM(acc, 4)
    gemm_core<true, false, 4>(p.xb, D, p.wt_up, D, D, m0, n0, acc, smem);
    STORE_TILE_BF16(acc, 4, p.ff, DFF, 0, fmaxf(v * rs, 0.f) * fmaxf(v * rs, 0.f))
  }
}
DI void phase_ple(const Params& p, int L, char* smem) {
  GEMM_IDS
  for (int id = blockIdx.x; id < 128 * 8; id += gridDim.x) {
    int tm, tn; map_tile(id, 8, tm, tn);
    const int m0 = tm * 128, n0 = tn * 128;
    f32x16 gt[2][2]; ZERO_ACC(gt)
    gemm_core<true>(p.xb, D, p.wt_pg, D, D, m0, n0, gt, smem);
    EPI_BEGIN(gt) gt[mt][nt][i] = sigmoidf_(v * rstd_s[rl]); EPI_END
    f32x16 acc[2][2]; ZERO_ACC(acc)
    gemm_core<false, false>(p.pb, 256, p.wt_pp, 256, 256, m0, n0, acc, smem);
    EPI_BEGIN(acc)
      float* xp = p.out + (size_t)row * 1024 + col;
      float nv = *xp + gt[mt][nt][i] * v; *xp = nv; p.xb2[(size_t)row * 1024 + col] = f2bf(nv);
    EPI_END
  }
  if (L + 1 < 4) {
    __syncthreads();
    for (int it = blockIdx.x; it < CV_NA + CV_NB; it += gridDim.x) {
      if (it < CV_NA) conv_item_A(p, L + 1, it, smem); else conv_item_B(p, L + 1, it - CV_NA, smem);
    }
  }
}

DI void grid_barrier() { cg::this_grid().sync(); }
DI void grid_barrier_light(unsigned* ctr, unsigned target) {
  asm volatile("s_waitcnt vmcnt(0)" ::: "memory");
  __syncthreads();
  if (TID() == 0) {
    __builtin_amdgcn_fence(__ATOMIC_RELEASE, "agent");
    asm volatile("s_waitcnt vmcnt(0)" ::: "memory");
    __hip_atomic_fetch_add(ctr, 1u, __ATOMIC_RELAXED, __HIP_MEMORY_SCOPE_AGENT);
    while (__hip_atomic_load(ctr, __ATOMIC_RELAXED, __HIP_MEMORY_SCOPE_AGENT) < target) { }
    __builtin_amdgcn_fence(__ATOMIC_ACQUIRE, "agent");
    asm volatile("s_waitcnt vmcnt(0)" ::: "memory");
  }
  __syncthreads();
}

__global__ void __launch_bounds__(256, 2) hybrid_megakernel(Params p) {
  __shared__ __attribute__((aligned(16))) char smem[SMEM_BYTES];
  unsigned epoch = 0;
  for (int ph = p.ph_lo; ph < p.ph_hi; ++ph) {
    const int L = ph / NPH, s = ph % NPH;
    if (s == 0 && L > 0) continue;
#ifdef ONLY
    if (s != ONLY) continue;
#endif
    switch (s) {
      case 0: phase_convert(p, L, smem); break;
      case 1: phase_in(p, L, smem); break;
      case 2: phase_prep(p, L, smem); break;
      case 3: phase_attn1(p, L, smem); break;
      case 4: phase_attn2(p, smem); break;
      case 5: phase_widen(p, smem); break;
      case 6: phase_resid(p, p.u, 1024, p.wt_o, 1024, smem); break;
      case 7: phase_up(p, smem); break;
      case 8: phase_resid(p, p.ff, DFF, p.wt_down, DFF, smem); break;
      case 9: phase_ple(p, L, smem); break;
    }
    if (ph + 1 < p.ph_hi) {
      if (ph == p.ph_lo) grid_barrier();
      else { ++epoch; grid_barrier_light(p.bar, epoch * gridDim.x); }
    }
  }
}

extern "C" void kernel_launch(void* const* d_in, const int* in_sizes, int n_in, void* d_out, int out_size, void* d_ws,
                              size_t ws_size, hipStream_t stream) {
  Params p;
  memset(&p, 0, sizeof(p));
  const float* const* in = (const float* const*)d_in;
  p.x = in[0]; p.p = in[1]; p.rel_bias = in[2]; p.norm_mix_g = in[3]; p.w_in = in[4]; p.mla_cq_g = in[5]; p.mla_ckv_g = in[6];
  p.mla_w_uq = in[7]; p.mla_w_ukv = in[8]; p.mla_qn_g = in[9]; p.mla_kn_g = in[10]; p.nsa_pe_k = in[11]; p.nsa_pe_v = in[12];
  p.nsa_w1_k = in[13]; p.nsa_w2_k = in[14]; p.nsa_w1_v = in[15]; p.nsa_w2_v = in[16]; p.nsa_qn_g = in[17]; p.nsa_kn_g = in[18];
  p.fox_f_bias = in[19]; p.fox_qn_g = in[20]; p.fox_kn_g = in[21]; p.w_branch = in[22]; p.w_o = in[23]; p.norm_mlp_g = in[24];
  p.w_up = in[25]; p.w_down = in[26]; p.norm_ple_g = in[27]; p.w_ple_gate = in[28]; p.w_ple_proj = in[29];
  p.out = (float*)d_out;
  char* ws = (char*)d_ws; size_t off = 0;
  auto take = [&](size_t bytes) { char* r = ws + off; off += (bytes + 255) & ~(size_t)255; return r; };
  p.wt_in = (bfu*)take((size_t)NINP * D * 2);
  p.wt_uq = (bfu*)take(384 * 384 * 2);
  p.wt_ukv = (bfu*)take(512 * 128 * 2);
  p.wt_br = (bfu*)take((size_t)4 * D * 256 * 2);
  p.wt_o = (bfu*)take((size_t)D * D * 2);
  p.wt_up = (bfu*)take((size_t)DFF * D * 2);
  p.wt_down = (bfu*)take((size_t)D * DFF * 2);
  p.wt_pg = (bfu*)take((size_t)D * D * 2);
  p.wt_pp = (bfu*)take((size_t)D * 256 * 2);
  p.xb = (bfu*)take((size_t)M * D * 2);
  p.pb = (bfu*)take((size_t)M * 256 * 2);
  char* projr = take((size_t)M * PJ * 2);
  p.proj = (bfu*)projr;
  p.cq = p.xb; p.ckv = p.xb + (size_t)M * 384;
  p.gates = (bfu*)take((size_t)M * 4096 * 2);
  p.ff = p.gates;
  p.y = (bfu*)take((size_t)M * D * 2);
  p.qraw = (bfu*)take((size_t)M * 384 * 2);
  p.kvraw = (bfu*)take((size_t)M * 512 * 2);
  p.small_ = (float*)take((size_t)M * 16 * 4);
  p.kcmp = (bfu*)take((size_t)(M + 32) * 64 * 2); p.vcmp = (bfu*)take((size_t)(M + 32) * 64 * 2);
  p.wt_w1 = (bfu*)take((size_t)2 * 128 * 2048 * 2);
  p.pebias = (float*)take(16 * 64 * 4);
  p.krope = (bfu*)take((size_t)M * 32 * 2);
  p.xb2 = p.y;
  p.q_sb = (bfu*)take((size_t)M * 256 * 2); p.k_sb = (bfu*)take((size_t)M * 256 * 2); p.vt_sb = (bfu*)take((size_t)M * 256 * 2);
  p.q_fox = (bfu*)take((size_t)M * 256 * 2); p.k_fox = (bfu*)take((size_t)M * 256 * 2); p.vt_fox = (bfu*)take((size_t)M * 256 * 2);
  p.q_nsa = (bfu*)take((size_t)M * 256 * 2);
  p.ks = (bfu*)take((size_t)M * 64 * 2); p.vts = (bfu*)take((size_t)M * 64 * 2); p.kw = (bfu*)take((size_t)M * 64 * 2); p.vtw = (bfu*)take((size_t)M * 64 * 2);
  p.cum = (float*)take((size_t)NB * H * S * 4);
  p.kc = (float*)take((size_t)NB * 128 * 64 * 4); p.vc = (float*)take((size_t)NB * 128 * 64 * 4);
  p.kc_b = (bfu*)take((size_t)NB * 128 * 64 * 2); p.vct_b = (bfu*)take((size_t)NB * 64 * 128 * 2);
  p.selmask = (unsigned*)take((size_t)M * 4);
  p.bar = (unsigned*)take(256);
  {
    size_t o2 = 0;
    p.u = (bfu*)(projr + o2); o2 += (size_t)M * D * 2;
    p.q_mla = (bfu*)(projr + o2); o2 += (size_t)M * 384 * 2;
    p.k_mla = (bfu*)(projr + o2); o2 += (size_t)M * 384 * 2;
    p.vt_mla = (bfu*)(projr + o2); o2 += (size_t)M * 256 * 2;
    p.ocmp = (float*)(projr + o2); o2 += (size_t)M * 256 * 4;
    if (o2 > (size_t)M * PJ * 2) fprintf(stderr, "alias overflow\n");
  }
  if (off > ws_size) fprintf(stderr, "workspace too small: need %zu have %zu\n", off, ws_size);

  static int grid_blocks = 0;
  if (!grid_blocks) {
    int dev = 0, cus = 0, per_cu = 0;
    hipGetDevice(&dev);
    hipDeviceGetAttribute(&cus, hipDeviceAttributeMultiprocessorCount, dev);
    hipOccupancyMaxActiveBlocksPerMultiprocessor(&per_cu, hybrid_megakernel, 256, 0);
    if (per_cu > 2) per_cu = 2;
    if (per_cu < 1) per_cu = 1;
    grid_blocks = cus * per_cu;
  }
#if MULTI
  for (int ph = 0; ph < 4 * NPH; ++ph) {
    p.ph_lo = ph; p.ph_hi = ph + 1;
    hipLaunchKernelGGL(hybrid_megakernel, dim3(grid_blocks), dim3(256), 0, stream, p);
  }
#else
  p.ph_lo = 0; p.ph_hi = 4 * NPH;
  hipMemsetAsync(p.bar, 0, 256, stream);
  void* args[] = {&p};
  hipError_t e = hipLaunchCooperativeKernel((void*)hybrid_megakernel, dim3(grid_blocks), dim3(256), args, 0, stream);
  if (e != hipSuccess) fprintf(stderr, "cooperative launch failed: %s (grid %d)\n", hipGetErrorString(e), grid_blocks);
#endif
}
```

```cpp
#include <hip/hip_runtime.h>
#include <hip/hip_cooperative_groups.h>
#include <cstdio>
#include <cstdint>
#include <cstring>
namespace cg = cooperative_groups;

#ifndef FUSE_MASK
#define FUSE_MASK 1
#endif
#ifndef MULTI
#define MULTI 0
#endif

typedef unsigned short bfu;
using bf16x8 = __attribute__((ext_vector_type(8))) short;
using s16x4  = __attribute__((ext_vector_type(4))) short;
using f32x16 = __attribute__((ext_vector_type(16))) float;
using u32x4  = __attribute__((ext_vector_type(4))) unsigned;
using u32x2  = __attribute__((ext_vector_type(2))) unsigned;
#define DI __device__ __forceinline__
#define MFMA(a, b, c) __builtin_amdgcn_mfma_f32_32x32x16_bf16((a), (b), (c), 0, 0, 0)

constexpr int NB = 8, S = 2048, D = 1024, M = NB * S, H = 4;
constexpr int NIN = 6832, NINP = 6912, PJ = 2752, PJN = 2736;
constexpr int DFF = 4096;
constexpr float EPS = 1e-6f;
constexpr int SMEM_BYTES = 60 * 1024;
constexpr int NPH = 10;

struct Params {
  const float *x, *p, *rel_bias, *norm_mix_g, *w_in, *mla_cq_g, *mla_ckv_g, *mla_w_uq, *mla_w_ukv, *mla_qn_g, *mla_kn_g;
  const float *nsa_pe_k, *nsa_pe_v, *nsa_w1_k, *nsa_w2_k, *nsa_w1_v, *nsa_w2_v, *nsa_qn_g, *nsa_kn_g;
  const float *fox_f_bias, *fox_qn_g, *fox_kn_g, *w_branch, *w_o, *norm_mlp_g, *w_up, *w_down, *norm_ple_g, *w_ple_gate, *w_ple_proj;
  float* out;
  bfu *wt_in, *wt_uq, *wt_ukv, *wt_br, *wt_o, *wt_up, *wt_down, *wt_pg, *wt_pp;
  bfu *xb, *xb2, *krope, *pb, *kcmp, *vcmp, *wt_w1, *kc_b, *vct_b, *cq, *ckv, *proj, *gates, *ff, *y, *u, *qraw, *kvraw;
  float* small_;
  bfu *q_sb, *k_sb, *vt_sb, *q_fox, *k_fox, *vt_fox, *q_nsa, *ks, *vts, *kw, *vtw, *q_mla, *k_mla, *vt_mla;
  float *cum, *kc, *vc, *ocmp, *pebias;
  unsigned* selmask;
  int ph_lo, ph_hi;
  unsigned* bar;
};

DI int TID() { int t = threadIdx.x; asm volatile("" : "+v"(t)); return t; }
DI bfu f2bf(float f) { __bf16 h = (__bf16)f; return __builtin_bit_cast(bfu, h); }
DI float bf2f(bfu b) { return __uint_as_float(((unsigned)b) << 16); }
typedef float f32x2_t __attribute__((ext_vector_type(2)));
typedef __bf16 bf16x2_t __attribute__((ext_vector_type(2)));
DI unsigned pk2(float a, float b) { f32x2_t v = {a, b}; bf16x2_t r_ = __builtin_convertvector(v, bf16x2_t); return __builtin_bit_cast(unsigned, r_); }
DI float bflo(unsigned u) { return __uint_as_float(u << 16); }
DI float bfhi(unsigned u) { return __uint_as_float(u & 0xffff0000u); }
DI float sigmoidf_(float v) { return 1.f / (1.f + __expf(-v)); }

#define PACK8(vec, base) __builtin_bit_cast(bf16x8, (u32x4){pk2((vec)[(base)+0], (vec)[(base)+1]), pk2((vec)[(base)+2], (vec)[(base)+3]), pk2((vec)[(base)+4], (vec)[(base)+5]), pk2((vec)[(base)+6], (vec)[(base)+7])})

DI int in_colmap(int n) {
  if (n < 1280) return n;
  if (n < 1920) return n + 32;
  if (n < 2688) return n + 44;
  if (n < 2720) return n - 2688 + 1280;
  if (n < 2732) return n - 2720 + 1952;
  if (n < 2736) return n;
  if (n < 2752) return -1;
  if (n < 6848) return n - 16;
  return -1;
}
template <bool MAP = false>
DI void conv_tile(const float* __restrict__ src, int N, int K, bfu* __restrict__ dst, const float* __restrict__ g,
                  int tk, int tn, char* smem, int ldk = -1) {
  const int LK = ldk < 0 ? K : ldk;
  float* T = (float*)smem;
  const int tid = TID();
  __syncthreads();
#pragma unroll
  for (int j = 0; j < 4; ++j) {
    int k = (tid >> 4) + 16 * j, n4 = (tid & 15) * 4;
    int gn = tn * 64 + n4, gk = tk * 64 + k;
    float4 v = make_float4(0.f, 0.f, 0.f, 0.f);
    const int og = MAP ? in_colmap(gn) : (gn < N ? gn : -1);
    if (og >= 0) v = *(const float4*)(src + (size_t)gk * N + og);
    float gg = g ? g[gk] : 1.f;
    T[k * 65 + n4 + 0] = v.x * gg; T[k * 65 + n4 + 1] = v.y * gg; T[k * 65 + n4 + 2] = v.z * gg; T[k * 65 + n4 + 3] = v.w * gg;
  }
  __syncthreads();
#pragma unroll
  for (int j = 0; j < 2; ++j) {
    int n = (tid >> 3) + 32 * j, kc = tid & 7;
    float e[8];
#pragma unroll
    for (int q = 0; q < 8; ++q) e[q] = T[(kc * 8 + q) * 65 + n];
    u32x4 o = {pk2(e[0], e[1]), pk2(e[2], e[3]), pk2(e[4], e[5]), pk2(e[6], e[7])};
    *(u32x4*)(dst + (size_t)(tn * 64 + n) * LK + tk * 64 + kc * 8) = o;
  }
}

constexpr int CV_NA = 16 * 108, CV_NB = 36 + 16 + 128 + 16, CV_NC = 256 + 256 + 1024 + 1024 + 256 + 64 + 2048, CV_NX = M * D / 2048;
DI void conv_item_A(const Params& p, int L, int t, char* smem) {
  conv_tile<true>(p.w_in + (size_t)L * D * NIN, NIN, D, p.wt_in, p.norm_mix_g + L * D, t / 108, t % 108, smem);
}
DI void conv_item_B(const Params& p, int L, int it, char* smem) {
  if (it < 36) { conv_tile(p.mla_w_uq + (size_t)L * 384 * 384, 384, 384, p.wt_uq, p.mla_cq_g + L * 384, it / 6, it % 6, smem); }
  else if (it < 52) { int t = it - 36; conv_tile(p.mla_w_ukv + (size_t)L * 128 * 512, 512, 128, p.wt_ukv, p.mla_ckv_g + L * 128, t / 8, t % 8, smem); }
  else if (it < 180) { int t = it - 52; int kv = t >> 6; t &= 63;
    conv_tile((kv ? p.nsa_w1_v : p.nsa_w1_k) + (size_t)L * 2048 * 64, 64, 2048, p.wt_w1 + (size_t)kv * 128 * 2048, nullptr, t >> 1, t & 1, smem); }
  else {
    const int q = it - 180; const int kv = q >> 3, kr = q & 7; const int tid = TID(); const int n = tid & 63, kq = tid >> 6;
    const float* w1 = (kv ? p.nsa_w1_v : p.nsa_w1_k) + (size_t)L * 2048 * 64;
    const float* pe = (kv ? p.nsa_pe_v : p.nsa_pe_k) + (size_t)L * 2048;
    float a = 0.f;
    const int kb = kr * 256 + kq * 64;
#pragma unroll 16
    for (int k = kb; k < kb + 64; ++k) a += pe[k] * w1[(size_t)k * 64 + n];
    float* red = (float*)smem;
    __syncthreads(); red[tid] = a; __syncthreads();
    if (tid < 64) p.pebias[(kv * 8 + kr) * 64 + tid] = (red[tid] + red[tid + 64]) + (red[tid + 128] + red[tid + 192]);
  }
}
DI void conv_item_C(const Params& p, int L, int it, char* smem) {
  if (it < 256) { int t = it; int n = t >> 6; t &= 63; conv_tile(p.w_branch + ((size_t)L * 4 + n) * 256 * D, D, 256, p.wt_br + (size_t)n * 256, nullptr, t / 16, t % 16, smem, 1024); }
  else if (it < 512) { int t = it - 256; conv_tile(p.w_o + (size_t)L * D * D, D, D, p.wt_o, nullptr, t / 16, t % 16, smem); }
  else if (it < 1536) { int t = it - 512; conv_tile(p.w_up + (size_t)L * D * DFF, DFF, D, p.wt_up, p.norm_mlp_g + L * D, t / 64, t % 64, smem); }
  else if (it < 2560) { int t = it - 1536; conv_tile(p.w_down + (size_t)L * DFF * D, D, DFF, p.wt_down, nullptr, t / 16, t % 16, smem); }
  else if (it < 2816) { int t = it - 2560; conv_tile(p.w_ple_gate + (size_t)L * D * D, D, D, p.wt_pg, p.norm_ple_g + L * D, t / 16, t % 16, smem); }
  else if (it < 2880) { int t = it - 2816; conv_tile(p.w_ple_proj + (size_t)L * 256 * D, D, 256, p.wt_pp, nullptr, t / 16, t % 16, smem); }
  else {
    size_t e = (size_t)(it - 2880) * 2048 + TID() * 8;
    const float* sp = p.p + (size_t)L * M * 256 + e;
    float4 a = *(const float4*)sp, b = *(const float4*)(sp + 4);
    *(u32x4*)(p.pb + e) = (u32x4){pk2(a.x, a.y), pk2(a.z, a.w), pk2(b.x, b.y), pk2(b.z, b.w)};
  }
}
DI void phase_convert(const Params& p, int L, char* smem) {
  const int total = CV_NA + CV_NB + CV_NC + CV_NX;
  for (int it = blockIdx.x; it < total; it += gridDim.x) {
    if (it < CV_NA) conv_item_A(p, L, it, smem);
    else if (it < CV_NA + CV_NB) conv_item_B(p, L, it - CV_NA, smem);
    else if (it < CV_NA + CV_NB + CV_NC) conv_item_C(p, L, it - CV_NA - CV_NB, smem);
    else {
      size_t e = (size_t)(it - CV_NA - CV_NB - CV_NC) * 2048 + TID() * 8;
      float4 a = *(const float4*)(p.x + e), b = *(const float4*)(p.x + e + 4);
      *(float4*)(p.out + e) = a; *(float4*)(p.out + e + 4) = b;
      *(u32x4*)(p.xb2 + e) = (u32x4){pk2(a.x, a.y), pk2(a.z, a.w), pk2(b.x, b.y), pk2(b.z, b.w)};
    }
  }
}

#define BAR_LDS() do { asm volatile("s_waitcnt lgkmcnt(0)" ::: "memory"); __builtin_amdgcn_s_barrier(); asm volatile("" ::: "memory"); } while (0)
constexpr int GP = 72;
constexpr int RSTD_OFF = 55296;
struct NoHook { DI void operator()(int) const {} };
template <bool NORM, bool DEEP, int MTW, int KSEG, class HOOK>
DI void gemm_core_h(const bfu* __restrict__ A, int lda, const bfu* __restrict__ Bt, int ldb, int K, int m0, int n0,
                    f32x16 (&acc)[MTW][2], char* smem, HOOK hook) {
  constexpr int NA = 2 * MTW;
  bfu* As = (bfu*)smem;
  bfu* Bs = As + 64 * MTW * GP;
  float* rstd_s = (float*)(smem + RSTD_OFF);
  const int tid = TID(), lane = tid & 63, w = tid >> 6, r = lane & 31, hh = lane >> 5;
  const int wm = w >> 1, wn = w & 1;
  const int lrow = tid >> 3, lkc = tid & 7;
  const unsigned aoff = (unsigned)((m0 + lrow) * lda + lkc * 8);
  const unsigned boff = (unsigned)((n0 + lrow) * ldb + lkc * 8);
#define AP_(j, k64) (A + (aoff + (unsigned)(32 * (j)) * (unsigned)lda + (unsigned)(k64)))
#define BP_(j, k64) (Bt + (boff + (unsigned)(32 * (j)) * (unsigned)ldb + (unsigned)(k64)))
  u32x4 ra0[NA], rb0[4], ra1[NA], rb1[4];
  float ssq[NA];
#pragma unroll
  for (int j = 0; j < NA; ++j) ssq[j] = 0.f;
  const int nk = K >> 6;
#pragma unroll
  for (int j = 0; j < NA; ++j) ra0[j] = *(const u32x4*)AP_(j, 0);
#pragma unroll
  for (int j = 0; j < 4; ++j) rb0[j] = *(const u32x4*)BP_(j, 0);
  if (DEEP) {
#pragma unroll
    for (int j = 0; j < NA; ++j) ra1[j] = *(const u32x4*)AP_(j, 64);
#pragma unroll
    for (int j = 0; j < 4; ++j) rb1[j] = *(const u32x4*)BP_(j, 64);
  }
#define GEMM_STEP(RA, RB, KT, DIST)                                                                                \
  {                                                                                                                \
    BAR_LDS();                                                                                                     \
    _Pragma("unroll") for (int j = 0; j < NA; ++j) *(u32x4*)(As + (lrow + 32 * j) * GP + lkc * 8) = RA[j];         \
    _Pragma("unroll") for (int j = 0; j < 4; ++j) *(u32x4*)(Bs + (lrow + 32 * j) * GP + lkc * 8) = RB[j];          \
    if (NORM) {                                                                                                    \
      _Pragma("unroll") for (int j = 0; j < NA; ++j) _Pragma("unroll") for (int e = 0; e < 4; ++e) {               \
        float lo = bflo(RA[j][e]), hi = bfhi(RA[j][e]); ssq[j] += lo * lo + hi * hi; }                             \
    }                                                                                                              \
    BAR_LDS();                                                                                                     \
    {                                                                                                              \
      const int kn_ = ((KT) + (DIST) < nk) ? ((KT) + (DIST)) : (nk - 1);       \
      _Pragma("unroll") for (int j = 0; j < NA; ++j) RA[j] = *(const u32x4*)AP_(j, kn_ * 64);                      \
      _Pragma("unroll") for (int j = 0; j < 4; ++j) RB[j] = *(const u32x4*)BP_(j, kn_ * 64);                       \
    }                                                                                                              \
    _Pragma("unroll") for (int ks = 0; ks < 4; ++ks) {                                                             \
      bf16x8 b0 = *(const bf16x8*)(Bs + (wn * 64 + r) * GP + ks * 16 + hh * 8);                                    \
      bf16x8 b1 = *(const bf16x8*)(Bs + (wn * 64 + 32 + r) * GP + ks * 16 + hh * 8);                               \
      _Pragma("unroll") for (int mt = 0; mt < MTW; ++mt) {                                                         \
        bf16x8 a_ = *(const bf16x8*)(As + (wm * 32 * MTW + mt * 32 + r) * GP + ks * 16 + hh * 8);                  \
        acc[mt][0] = MFMA(a_, b0, acc[mt][0]); acc[mt][1] = MFMA(a_, b1, acc[mt][1]);                              \
      }                                                                                                            \
    }                                                                                                              \
  }
  if (DEEP) {
    for (int kt = 0; kt < nk; kt += 2) {
      GEMM_STEP(ra0, rb0, kt, 2)
      GEMM_STEP(ra1, rb1, kt + 1, 2)
    }
  } else {
    for (int kt = 0; kt < nk; ++kt) {
      GEMM_STEP(ra0, rb0, kt, 1)
      if (KSEG > 0) { if (((kt + 1) % (KSEG > 0 ? KSEG : 1)) == 0) hook((kt + 1) / (KSEG > 0 ? KSEG : 1) - 1); }
    }
  }
#undef GEMM_STEP
#undef AP_
#undef BP_
  if (NORM) {
#pragma unroll
    for (int j = 0; j < NA; ++j) {
      float v = ssq[j];
      v += __shfl_xor(v, 1); v += __shfl_xor(v, 2); v += __shfl_xor(v, 4);
      if (lkc == 0) rstd_s[lrow + 32 * j] = rsqrtf(v / (float)K + EPS);
    }
  }
  __syncthreads();
}

template <bool NORM, bool DEEP = true, int MTW = 2>
DI void gemm_core(const bfu* __restrict__ A, int lda, const bfu* __restrict__ Bt, int ldb, int K, int m0, int n0,
                  f32x16 (&acc)[MTW][2], char* smem) {
  gemm_core_h<NORM, DEEP, MTW, 0, NoHook>(A, lda, Bt, ldb, K, m0, n0, acc, smem, NoHook());
}

#define ZERO_ACC(a) ZERO_ACCM(a, 2)
#define ZERO_ACCM(a, MT) _Pragma("unroll") for (int _m = 0; _m < MT; ++_m) _Pragma("unroll") for (int _n = 0; _n < 2; ++_n) _Pragma("unroll") for (int _i = 0; _i < 16; ++_i) a[_m][_n][_i] = 0.f;

#define EPI_BEGIN(accv) EPI_BEGINM(accv, 2)
#define EPI_BEGINM(accv, MT)                                                                                    \
  _Pragma("unroll") for (int mt = 0; mt < MT; ++mt) _Pragma("unroll") for (int nt = 0; nt < 2; ++nt)              \
  _Pragma("unroll") for (int i = 0; i < 16; ++i) {                                                              \
    const int rl = wm * 32 * MT + mt * 32 + (i & 3) + 8 * (i >> 2) + 4 * hh;                                      \
    const int row = m0 + rl; const int col = n0 + wn * 64 + nt * 32 + r; float v = accv[mt][nt][i];               \
    (void)rl; (void)row; (void)col; (void)v;
#define EPI_END }

#define GEMM_IDS const int tid = TID(), lane = tid & 63, w = tid >> 6, r = lane & 31, hh = lane >> 5, wm = w >> 1, wn = w & 1; \
  const float* rstd_s = (const float*)(smem + RSTD_OFF); (void)rstd_s; (void)r; (void)hh; (void)wm; (void)wn;

DI void map_tile(int id, int NT, int& mt, int& nt) {
  int x = id & 7, idx = id >> 3;
  int srl = idx / (8 * NT), rem = idx % (8 * NT);
  nt = rem >> 3; int mi = rem & 7;
  mt = (srl * 8 + x) * 8 + mi;
}

#define STORE_TILE_BF16(accv, MT, BASE, LD, COLOFF, OP)                                                           \
  _Pragma("unroll") for (int mt = 0; mt < MT; ++mt) _Pragma("unroll") for (int ip = 0; ip < 8; ++ip) {             \
    const int i0 = 2 * ip;                                                                                        \
    const int rl0 = wm * 32 * MT + mt * 32 + (i0 & 3) + 8 * (i0 >> 2) + 4 * hh;                                    \
    const float rs0 = rstd_s[rl0], rs1 = rstd_s[rl0 + 1]; (void)rs0; (void)rs1;                                    \
    _Pragma("unroll") for (int nt = 0; nt < 2; ++nt) {                                                            \
      float va; { const float v = accv[mt][nt][i0]; const float rs = rs0; (void)rs; va = (OP); }                   \
      float vb; { const float v = accv[mt][nt][i0 + 1]; const float rs = rs1; (void)rs; vb = (OP); }               \
      const float snd = (r & 1) ? va : vb;                                                                        \
      const float rcv = __shfl_xor(snd, 1);                                                                       \
      const unsigned pk_ = (r & 1) ? pk2(rcv, vb) : pk2(va, rcv);                                                  \
      const unsigned off_ = (unsigned)(m0 + rl0 + (r & 1)) * (unsigned)(LD) + (unsigned)((COLOFF) + n0 + wn * 64 + nt * 32 + (r & ~1)); \
      *(unsigned*)((BASE) + off_) = pk_;                                                                          \
    }                                                                                                             \
  }

DI void phase_in(const Params& p, int L, char* smem) {
  GEMM_IDS
  const int NT = NINP / 128;
  for (int id = blockIdx.x; id < 64 * NT; id += gridDim.x) {
    int tm, tn; map_tile(id, NT, tm, tn);
    const int m0 = tm * 256, n0 = tn * 128;
    f32x16 acc[4][2]; ZERO_ACCM(acc, 4)
    gemm_core<true, false, 4>(p.xb2, D, p.wt_in, D, D, m0, n0, acc, smem);
    const int cb = (n0 >> 6) + wn;
    const int b = m0 >> 11;
    const int sb = (m0 & (S - 1)) + wm * 128;
#pragma unroll
    for (int mt = 0; mt < 4; ++mt)
#pragma unroll
      for (int i = 0; i < 16; ++i) {
        const float rs = rstd_s[wm * 128 + mt * 32 + (i & 3) + 8 * (i >> 2) + 4 * hh];
        acc[mt][0][i] *= rs; acc[mt][1][i] *= rs;
      }
    int grp_;
    if (cb >= 43) grp_ = 16;
    else if (cb < 8) grp_ = 1;
    else if ((cb >= 20 && cb < 24) || cb == 26 || cb == 28 || (cb >= 30 && cb < 38)) grp_ = 2;
    else if ((cb >= 8 && cb < 12) || cb == 27 || cb == 29 || (cb >= 38 && cb < 42)) grp_ = 4;
    else grp_ = 8;
    const bool fused_ = (grp_ == 16) || ((FUSE_MASK & grp_) != 0);
    if (!fused_) {
      EPI_BEGINM(acc, 4)
        const int oc = in_colmap(col);
        if (oc >= 0 && oc < PJN) {
          p.proj[(size_t)row * PJ + oc] = f2bf(v);
          if (oc >= 1952 && oc < 1964) p.small_[row * 16 + (oc - 1952)] = v;
          if (oc >= 2732) p.small_[row * 16 + 12 + (oc - 2732)] = v;
          if (oc >= 1568 && oc < 1632) p.kcmp[(size_t)row * 64 + (oc - 1568)] = f2bf(v);
          if (oc >= 1632 && oc < 1696) p.vcmp[(size_t)row * 64 + (oc - 1632)] = f2bf(v);
        }
      EPI_END
    } else
    if (cb >= 43) {
      if (cb < 107) {
        EPI_BEGINM(acc, 4) p.gates[(size_t)row * 4096 + (col - 2752)] = f2bf(sigmoidf_(v)); EPI_END
      }
    } else if (cb < 8 || (cb >= 20 && cb < 24) || cb == 26 || cb == 28 || (cb >= 30 && cb < 38)) {
      const float* g = nullptr; float sc = 1.f; bfu* dst;
      if (cb < 4)       { sc = 0.125f; dst = p.q_sb + ((size_t)(b * 4 + cb) * S) * 64; }
      else if (cb < 8)  { dst = p.k_sb + ((size_t)(b * 4 + cb - 4) * S) * 64; }
      else if (cb < 24) { g = p.nsa_qn_g + L * 64; sc = 0.125f; dst = p.q_nsa + ((size_t)(b * 4 + cb - 20) * S) * 64; }
      else if (cb == 26) { g = p.nsa_kn_g + (L * 3 + 1) * 64; dst = p.ks + ((size_t)b * S) * 64; }
      else if (cb == 28) { g = p.nsa_kn_g + (L * 3 + 2) * 64; dst = p.kw + ((size_t)b * S) * 64; }
      else if (cb < 34) { g = p.fox_qn_g + L * 64; sc = 0.125f; dst = p.q_fox + ((size_t)(b * 4 + cb - 30) * S) * 64; }
      else              { g = p.fox_kn_g + L * 64; dst = p.k_fox + ((size_t)(b * 4 + cb - 34) * S) * 64; }
      float g0 = sc, g1 = sc;
      if (g) { g0 = g[r] * sc; g1 = g[32 + r] * sc; }
#pragma unroll
      for (int mt = 0; mt < 4; ++mt)
#pragma unroll
        for (int i = 0; i < 16; ++i) {
          float v0 = acc[mt][0][i], v1 = acc[mt][1][i];
          float rs = 1.f;
          if (g) {
            float ss = v0 * v0 + v1 * v1;
            ss += __shfl_xor(ss, 1); ss += __shfl_xor(ss, 2); ss += __shfl_xor(ss, 4); ss += __shfl_xor(ss, 8); ss += __shfl_xor(ss, 16);
            rs = rsqrtf(ss * (1.f / 64.f) + EPS);
          }
          const int sq = sb + mt * 32 + (i & 3) + 8 * (i >> 2) + 4 * hh;
          dst[(size_t)sq * 64 + r] = f2bf(v0 * rs * g0);
          dst[(size_t)sq * 64 + 32 + r] = f2bf(v1 * rs * g1);
        }
    } else if ((cb >= 8 && cb < 12) || cb == 27 || cb == 29 || cb >= 38) {
      if (cb < 42) {
        bfu* dst;
        if (cb < 12) dst = p.vt_sb + ((size_t)(b * 4 + cb - 8) * 64) * S;
        else if (cb == 27) dst = p.vts + ((size_t)b * 64) * S;
        else if (cb == 29) dst = p.vtw + ((size_t)b * 64) * S;
        else dst = p.vt_fox + ((size_t)(b * 4 + cb - 38) * 64) * S;
#pragma unroll
        for (int mt = 0; mt < 4; ++mt)
#pragma unroll
          for (int nt = 0; nt < 2; ++nt)
#pragma unroll
            for (int g4 = 0; g4 < 4; ++g4) {
              const int sq = sb + mt * 32 + 8 * g4 + 4 * hh;
              u32x2 v = {pk2(acc[mt][nt][4 * g4], acc[mt][nt][4 * g4 + 1]), pk2(acc[mt][nt][4 * g4 + 2], acc[mt][nt][4 * g4 + 3])};
              *(u32x2*)(dst + (size_t)(nt * 32 + r) * S + sq) = v;
            }
      } else {
#pragma unroll
        for (int mt = 0; mt < 4; ++mt)
#pragma unroll
          for (int i = 0; i < 16; ++i) {
            const size_t row = (size_t)m0 + wm * 128 + mt * 32 + (i & 3) + 8 * (i >> 2) + 4 * hh;
            p.krope[row * 32 + r] = f2bf(acc[mt][0][i]);
            if (r < 16) p.small_[row * 16 + r] = acc[mt][1][i];
          }
      }
    } else {
      bfu* dst; int ld, c0;
      if (cb < 18) { dst = p.cq; ld = 384; c0 = (cb - 12) * 64; }
      else if (cb < 20) { dst = p.ckv; ld = 128; c0 = (cb - 18) * 64; }
      else if (cb == 24) { dst = p.kcmp; ld = 64; c0 = 0; }
      else { dst = p.vcmp; ld = 64; c0 = 0; }
#pragma unroll
      for (int mt = 0; mt < 4; ++mt)
#pragma unroll
        for (int i = 0; i < 16; ++i) {
          const size_t row = (size_t)m0 + wm * 128 + mt * 32 + (i & 3) + 8 * (i >> 2) + 4 * hh;
          dst[row * ld + c0 + r] = f2bf(acc[mt][0][i]);
          dst[row * ld + c0 + 32 + r] = f2bf(acc[mt][1][i]);
        }
    }
  }
}

constexpr int TP = 66;
DI void tr_load(const bfu* __restrict__ src, int pitch, bfu* T) {
  const int tid = TID();
#pragma unroll
  for (int j = 0; j < 4; ++j) {
    int c = tid + 256 * j; int tok = c >> 4, q = c & 15;
    u32x2 v = *(const u32x2*)(src + (size_t)tok * pitch + q * 4);
    *(unsigned*)(T + tok * TP + q * 4) = v[0];
    *(unsigned*)(T + tok * TP + q * 4 + 2) = v[1];
  }
}
DI void tr_store(const bfu* T, bfu* __restrict__ dst  ) {
  const int tid = TID();
#pragma unroll
  for (int j = 0; j < 2; ++j) {
    int c = tid + 256 * j; int d = c & 63, tc = c >> 6;
    bfu e[8];
#pragma unroll
    for (int q = 0; q < 8; ++q) e[q] = T[(tc * 8 + q) * TP + d];
    u32x4 o = {(unsigned)e[0] | ((unsigned)e[1] << 16), (unsigned)e[2] | ((unsigned)e[3] << 16), (unsigned)e[4] | ((unsigned)e[5] << 16), (unsigned)e[6] | ((unsigned)e[7] << 16)};
    *(u32x4*)(dst + (size_t)d * S + tc * 8) = o;
  }
}

DI void prep_item(const Params& p, int L, int item, char* smem) {
  const int tid = TID();
  const int b = item >> 5, s0 = (item & 31) * 64;
  const size_t t0 = (size_t)b * S + s0;
  const int sub = tid & 7;
#pragma unroll 1
  for (int jb = 0; jb < 44; jb += 4) {
    u32x2 v0[4], v1[4];
#pragma unroll
    for (int u = 0; u < 4; ++u) {
      const int job = (tid >> 3) + 32 * (jb + u);
      const int tok = job & 63, vec = job >> 6;
      int col;
      if (vec < 4) col = 64 * vec; else if (vec < 8) col = 256 + 64 * (vec - 4); else if (vec < 12) col = 1964 + 64 * (vec - 8);
      else if (vec < 16) col = 2220 + 64 * (vec - 12); else if (vec < 20) col = 1312 + 64 * (vec - 16); else if (vec == 20) col = 1696; else col = 1824;
      const bfu* src = p.proj + (t0 + tok) * PJ + col + sub * 8;
      v0[u] = *(const u32x2*)src; v1[u] = *(const u32x2*)(src + 4);
    }
#pragma unroll
    for (int u = 0; u < 4; ++u) {
      const int job = (tid >> 3) + 32 * (jb + u);
      const int tok = job & 63, vec = job >> 6;
      if ((vec < 8) ? (FUSE_MASK & 1) : (FUSE_MASK & 2)) continue;
      const float* g = nullptr; float sc = 1.f; bfu* dst;
      if (vec < 4)       { sc = 0.125f; dst = p.q_sb + (((size_t)(b * 4 + vec)) * S + s0 + tok) * 64; }
      else if (vec < 8)  { int h = vec - 4; dst = p.k_sb + (((size_t)(b * 4 + h)) * S + s0 + tok) * 64; }
      else if (vec < 12) { int h = vec - 8; g = p.fox_qn_g + L * 64; sc = 0.125f; dst = p.q_fox + (((size_t)(b * 4 + h)) * S + s0 + tok) * 64; }
      else if (vec < 16) { int h = vec - 12; g = p.fox_kn_g + L * 64; dst = p.k_fox + (((size_t)(b * 4 + h)) * S + s0 + tok) * 64; }
      else if (vec < 20) { int h = vec - 16; g = p.nsa_qn_g + L * 64; sc = 0.125f; dst = p.q_nsa + (((size_t)(b * 4 + h)) * S + s0 + tok) * 64; }
      else if (vec == 20) { g = p.nsa_kn_g + (L * 3 + 1) * 64; dst = p.ks + ((size_t)b * S + s0 + tok) * 64; }
      else               { g = p.nsa_kn_g + (L * 3 + 2) * 64; dst = p.kw + ((size_t)b * S + s0 + tok) * 64; }
      float e[8] = {bflo(v0[u][0]), bfhi(v0[u][0]), bflo(v0[u][1]), bfhi(v0[u][1]), bflo(v1[u][0]), bfhi(v1[u][0]), bflo(v1[u][1]), bfhi(v1[u][1])};
      float ss = 0.f;
#pragma unroll
      for (int q = 0; q < 8; ++q) ss += e[q] * e[q];
      ss += __shfl_xor(ss, 1); ss += __shfl_xor(ss, 2); ss += __shfl_xor(ss, 4);
      const float rs = g ? rsqrtf(ss * (1.f / 64.f) + EPS) * sc : sc;
#pragma unroll
      for (int q = 0; q < 8; ++q) e[q] = e[q] * rs * (g ? g[sub * 8 + q] : 1.f);
      *(u32x4*)(dst + sub * 8) = (u32x4){pk2(e[0], e[1]), pk2(e[2], e[3]), pk2(e[4], e[5]), pk2(e[6], e[7])};
    }
  }
  if (!(FUSE_MASK & 8)) {
    const int tok = tid >> 2, sub = tid & 3;
    *(u32x4*)(p.krope + (t0 + tok) * 32 + sub * 8) = *(const u32x4*)(p.proj + (t0 + tok) * PJ + 1280 + sub * 8);
  }
  bfu* T = (bfu*)smem;
  if (!(FUSE_MASK & 4))
  for (int grp = 0; grp < 2; ++grp) {
    __syncthreads();
#pragma unroll 1
    for (int q = 0; q < 5; ++q) {
      int v = grp * 5 + q; int col;
      if (v < 4) col = 512 + 64 * v; else if (v < 8) col = 2476 + 64 * (v - 4); else if (v == 8) col = 1760; else col = 1888;
      tr_load(p.proj + t0 * PJ + col, PJ, T + q * 64 * TP);
    }
    __syncthreads();
#pragma unroll 1
    for (int q = 0; q < 5; ++q) {
      int v = grp * 5 + q; bfu* dst;
      if (v < 4) dst = p.vt_sb + ((size_t)(b * 4 + v) * 64) * S + s0;
      else if (v < 8) dst = p.vt_fox + ((size_t)(b * 4 + (v - 4)) * 64) * S + s0;
      else if (v == 8) dst = p.vts + ((size_t)b * 64) * S + s0;
      else dst = p.vtw + ((size_t)b * 64) * S + s0;
      tr_store(T + q * 64 * TP, dst);
    }
  }
}

DI void compress_item(const Params& p, int L, int item, char* smem) {
  GEMM_IDS
  const int b = item >> 1, kv = item & 1;
  const int m0 = 0, n0 = 0;
  f32x16 acc[2][2]; ZERO_ACC(acc)
  gemm_core<false>((kv ? p.vcmp : p.kcmp) + (size_t)b * S * 64, 1024, p.wt_w1 + (size_t)kv * 128 * 2048, 2048, 2048, 0, 0, acc, smem);
  float* Hs = (float*)smem;
  float* W2 = (float*)(smem + 128 * 65 * 4);
  const float* w2 = (kv ? p.nsa_w2_v : p.nsa_w2_k) + (size_t)L * 64 * 64;
  for (int e = tid; e < 1024; e += 256) *(float4*)(W2 + e * 4) = *(const float4*)(w2 + e * 4);
  if (wn == 0) {
#pragma unroll
    for (int mt = 0; mt < 2; ++mt)
#pragma unroll
      for (int nt = 0; nt < 2; ++nt)
#pragma unroll
        for (int i = 0; i < 16; ++i) {
          const int rl = wm * 64 + mt * 32 + (i & 3) + 8 * (i >> 2) + 4 * hh;
          const int n = nt * 32 + r;
          float pb_ = 0.f;
#pragma unroll
          for (int q8 = 0; q8 < 8; ++q8) pb_ += p.pebias[(kv * 8 + q8) * 64 + n];
          const float hsum = acc[mt][nt][i] + pb_;
          Hs[rl * 65 + n] = hsum / (1.f + __expf(-hsum));
        }
  }
  (void)m0; (void)n0;
  __syncthreads();
  const int row = tid >> 1, nh = tid & 1;
  float o[32];
#pragma unroll
  for (int j = 0; j < 32; ++j) o[j] = 0.f;
  for (int k = 0; k < 64; ++k) {
    const float hk = Hs[row * 65 + k];
    const float* wr = W2 + k * 64 + nh * 32;
#pragma unroll
    for (int j = 0; j < 32; j += 4) { float4 w4 = *(const float4*)(wr + j); o[j] += hk * w4.x; o[j + 1] += hk * w4.y; o[j + 2] += hk * w4.z; o[j + 3] += hk * w4.w; }
  }
  if (kv == 0) {
    float ss = 0.f;
#pragma unroll
    for (int j = 0; j < 32; ++j) ss += o[j] * o[j];
    ss += __shfl_xor(ss, 1);
    const float rs = rsqrtf(ss * (1.f / 64.f) + EPS);
    const float* g = p.nsa_kn_g + (L * 3 + 0) * 64 + nh * 32;
#pragma unroll
    for (int j = 0; j < 32; ++j) o[j] = o[j] * rs * g[j];
  }
  if (row == 127) {
#pragma unroll
    for (int j = 0; j < 32; ++j) o[j] = 0.f;
  }
  if (kv == 0) {
    bfu* dst = p.kc_b + ((size_t)b * 128 + row) * 64 + nh * 32;
#pragma unroll
    for (int j = 0; j < 32; j += 8) *(u32x4*)(dst + j) = (u32x4){pk2(o[j], o[j + 1]), pk2(o[j + 2], o[j + 3]), pk2(o[j + 4], o[j + 5]), pk2(o[j + 6], o[j + 7])};
  } else {
    bfu* dst = p.vct_b + ((size_t)b * 64 + nh * 32) * 128 + row;
#pragma unroll
    for (int j = 0; j < 32; ++j) dst[(size_t)j * 128] = f2bf(o[j]);
  }
  __syncthreads();
}

DI void foxcum_item(const Params& p, int L, int item) {
  const int tid = TID(), lane = tid & 63, w = tid >> 6;
  const int job = item * 4 + w;
  const int b = job >> 2, h = job & 3;
  const float fb = p.fox_f_bias[L * 4 + h];
  float v[32]; float run = 0.f;
#pragma unroll
  for (int q = 0; q < 32; ++q) {
    float z = p.small_[((size_t)b * S + lane * 32 + q) * 16 + 12 + h] + fb;
    float ls = fminf(z, 0.f) - __logf(1.f + __expf(-fabsf(z)));
    run += ls; v[q] = run;
  }
  float inc = run;
#pragma unroll
  for (int q = 1; q < 64; q <<= 1) { float t = __shfl_up(inc, q); if (lane >= q) inc += t; }
  float excl = inc - run;
#pragma unroll
  for (int q = 0; q < 32; ++q) p.cum[((size_t)(b * 4 + h)) * S + lane * 32 + q] = v[q] + excl;
}

DI void phase_prep(const Params& p, int L, char* smem) {
  GEMM_IDS
  const int N_CMP = 16, N_PREP = (FUSE_MASK & 15) == 15 ? 0 : 256, N_G2 = 128 * 3, N_G3 = 128 * 4, N_FC = 8;
  const int o1 = N_CMP, o2 = o1 + N_FC, o3 = o2 + N_PREP, o4 = o3 + N_G2, o5 = o4 + N_G3;
  const int G = (int)gridDim.x, NSK = N_CMP;
  for (int it0 = blockIdx.x; ; it0 += G) {
    int it;
    if (it0 < G) it = it0;
    else { const int rnd = it0 / G, pos = it0 - rnd * G; if (pos < NSK) break; it = G + (rnd - 1) * (G - NSK) + (pos - NSK); }
    if (it >= o5) break;
    if (it < o1) compress_item(p, L, it, smem);
    else if (it < o2) foxcum_item(p, L, it - o1);
    else if (it < o3) prep_item(p, L, it - o2, smem);
    else if (it < o4) {
      const int t = it - o3; const int m0 = (t / 3) * 128, n0 = (t % 3) * 128;
      f32x16 acc[2][2]; ZERO_ACC(acc)
      if (FUSE_MASK & 8) gemm_core<true>(p.cq, 384, p.wt_uq, 384, 384, m0, n0, acc, smem);
      else gemm_core<true>(p.proj + 768, PJ, p.wt_uq, 384, 384, m0, n0, acc, smem);
      EPI_BEGIN(acc) p.qraw[(size_t)row * 384 + col] = f2bf(v * rstd_s[rl]); EPI_END
    } else {
      const int t = it - o4; const int m0 = (t >> 2) * 128, n0 = (t & 3) * 128;
      f32x16 acc[2][2]; ZERO_ACC(acc)
      if (FUSE_MASK & 8) gemm_core<true>(p.ckv, 128, p.wt_ukv, 128, 128, m0, n0, acc, smem);
      else gemm_core<true>(p.proj + 1152, PJ, p.wt_ukv, 128, 128, m0, n0, acc, smem);
      EPI_BEGIN(acc) p.kvraw[(size_t)row * 512 + col] = f2bf(v * rstd_s[rl]); EPI_END
    }
  }
}

DI void mlaprep_item(const Params& p, int L, int item, char* smem) {
  const int tid = TID();
  const int b = item >> 5, s0 = (item & 31) * 64;
  const int tok = tid >> 2, h = tid & 3;
  const int spos = s0 + tok;
  const size_t t = (size_t)b * S + spos;
#pragma unroll 1
  for (int which = 0; which < 2; ++which) {
    const bfu* srcA = which ? (p.kvraw + t * 512 + h * 128) : (p.qraw + t * 384 + h * 96);
    const bfu* srcB = which ? (p.krope + t * 32) : (p.qraw + t * 384 + h * 96 + 64);
    const float* g = (which ? p.mla_kn_g : p.mla_qn_g) + L * 96;
    float ss = 0.f;
#pragma unroll
    for (int c = 0; c < 12; ++c) {
      u32x4 v = *(const u32x4*)((c < 8) ? (srcA + c * 8) : (srcB + (c - 8) * 8));
#pragma unroll
      for (int q = 0; q < 4; ++q) { float lo = bflo(v[q]), hi = bfhi(v[q]); ss += lo * lo + hi * hi; }
    }
    const float sc = which ? 1.f : 0.10206207261596577f;
    const float rs = rsqrtf(ss * (1.f / 96.f) + EPS) * sc;
    bfu* dst = (which ? p.k_mla : p.q_mla) + (((size_t)(b * 4 + h)) * S + spos) * 96;
#pragma unroll
    for (int c = 0; c < 8; ++c) {
      u32x4 v = *(const u32x4*)(srcA + c * 8);
      const float* gc = g + c * 8;
      *(u32x4*)(dst + c * 8) = (u32x4){pk2(bflo(v[0]) * rs * gc[0], bfhi(v[0]) * rs * gc[1]), pk2(bflo(v[1]) * rs * gc[2], bfhi(v[1]) * rs * gc[3]),
                                       pk2(bflo(v[2]) * rs * gc[4], bfhi(v[2]) * rs * gc[5]), pk2(bflo(v[3]) * rs * gc[6], bfhi(v[3]) * rs * gc[7])};
    }
#pragma unroll
    for (int c = 0; c < 2; ++c) {
      u32x4 va = *(const u32x4*)(srcB + c * 8);
      u32x4 vb = *(const u32x4*)(srcB + 16 + c * 8);
      float oa[8], ob[8];
#pragma unroll
      for (int q = 0; q < 8; ++q) {
        const int i2 = c * 8 + q;
        float a = ((q & 1) ? bfhi(va[q >> 1]) : bflo(va[q >> 1])) * rs * g[64 + i2];
        float bb = ((q & 1) ? bfhi(vb[q >> 1]) : bflo(vb[q >> 1])) * rs * g[80 + i2];
        float inv = expf(-9.210340371976184f * (float)i2 / 16.f);
        float ang = (float)spos * inv;
        double rv = (double)ang * 0.15915494309189535; rv -= floor(rv);
        float fr = (float)rv;
        float cs = __builtin_amdgcn_cosf(fr), sn = __builtin_amdgcn_sinf(fr);
        oa[q] = a * cs - bb * sn; ob[q] = bb * cs + a * sn;
      }
      *(u32x4*)(dst + 64 + c * 8) = (u32x4){pk2(oa[0], oa[1]), pk2(oa[2], oa[3]), pk2(oa[4], oa[5]), pk2(oa[6], oa[7])};
      *(u32x4*)(dst + 80 + c * 8) = (u32x4){pk2(ob[0], ob[1]), pk2(ob[2], ob[3]), pk2(ob[4], ob[5]), pk2(ob[6], ob[7])};
    }
  }
  bfu* T = (bfu*)smem;
  __syncthreads();
#pragma unroll 1
  for (int q = 0; q < 4; ++q) tr_load(p.kvraw + ((size_t)b * S + s0) * 512 + q * 128 + 64, 512, T + q * 64 * TP);
  __syncthreads();
#pragma unroll 1
  for (int q = 0; q < 4; ++q) tr_store(T + q * 64 * TP, p.vt_mla + ((size_t)(b * 4 + q) * 64) * S + s0);
}

DI int rel_bucket_dev(int d) {
  if (d < 16) return d;
  int v = 16 + (int)(logf((float)d / 16.f) / 2.0794415416798357f * 16.f);
  return v < 31 ? v : 31;
}

DI void nsacmp_item(const Params& p, int L, int item, char* smem) {
  (void)L;
  const int tid = TID(), lane = tid & 63, w = __builtin_amdgcn_readfirstlane(tid >> 6), r = lane & 31, hh = lane >> 5;
  const int b = item >> 6, s0 = (item & 63) * 32;
  constexpr int CKP = 72, CVP = 136;
  bfu* Ks = (bfu*)smem;
  bfu* Vt = (bfu*)(smem + 18432);
  float* lut = (float*)(smem + 35840);
  float* impx = (float*)(smem + 37952);
  const int tmax = s0 + 31;
  const int ncv_max = tmax >= 31 ? (tmax - 31) / 16 + 1 : 0;
  const int nct = (ncv_max + 31) >> 5;
  __syncthreads();
#pragma unroll
  for (int j = 0; j < 4; ++j) {
    const int c = tid + 256 * j;
    const int row = c >> 3, kc8 = c & 7;
    *(u32x4*)(Ks + row * CKP + kc8 * 8) = *(const u32x4*)(p.kc_b + ((size_t)b * 128 + row) * 64 + kc8 * 8);
    const int d = c >> 4, cc = c & 15;
    *(u32x4*)(Vt + d * CVP + cc * 8) = *(const u32x4*)(p.vct_b + ((size_t)b * 64 + d) * 128 + cc * 8);
  }
  for (int e = tid; e < 4 * 129; e += 256) { int hq = e / 129, d = e % 129; lut[hq * 132 + d] = p.rel_bias[rel_bucket_dev(d) * 4 + hq]; }
  __syncthreads();
  const int h = w;
  const int spos = s0 + r;
  const size_t t = (size_t)b * S + spos;
  bf16x8 qf[4];
#pragma unroll
  for (int ks = 0; ks < 4; ++ks) qf[ks] = *(const bf16x8*)(p.q_nsa + (((size_t)(b * 4 + h)) * S + spos) * 64 + ks * 16 + hh * 8);
  f32x16 sc[4];
#pragma unroll
  for (int ct = 0; ct < 4; ++ct) {
#pragma unroll
    for (int i = 0; i < 16; ++i) sc[ct][i] = 0.f;
    if (ct < nct) {
#pragma unroll
      for (int ks = 0; ks < 4; ++ks) {
        bf16x8 a = *(const bf16x8*)(Ks + (32 * ct + r) * CKP + ks * 16 + hh * 8);
        sc[ct] = MFMA(a, qf[ks], sc[ct]);
      }
    }
  }
  const int ncv = spos >= 31 ? (spos - 31) / 16 + 1 : 0;
  const float* lutl = lut + h * 132;
  float mx = -INFINITY;
#pragma unroll
  for (int ct = 0; ct < 4; ++ct)
#pragma unroll
    for (int i = 0; i < 16; ++i) {
      const int c = 32 * ct + (i & 3) + 8 * (i >> 2) + 4 * hh;
      int dd = spos - 16 * c - 31; dd = dd < 0 ? 0 : (dd > 128 ? 128 : dd);
      const float sv = (c < ncv) ? (sc[ct][i] + lutl[dd]) : -INFINITY;
      sc[ct][i] = sv; mx = fmaxf(mx, sv);
    }
  mx = fmaxf(mx, __shfl_xor(mx, 32));
  const float m_use = (mx == -INFINITY) ? 0.f : mx;
  float l = 0.f;
#pragma unroll
  for (int ct = 0; ct < 4; ++ct)
#pragma unroll
    for (int i = 0; i < 16; ++i) { const float pv = __expf(sc[ct][i] - m_use); sc[ct][i] = pv; l += pv; }
  l += __shfl_xor(l, 32);
  const float il = (l > 0.f) ? 1.f / l : 0.f;
#pragma unroll
  for (int ct = 0; ct < 4; ++ct)
#pragma unroll
    for (int i = 0; i < 16; ++i) sc[ct][i] *= il;
  {
    float* imr = impx + (h * 32 + r) * 33;
    float prev = 0.f;
#pragma unroll
    for (int ct = 0; ct < 4; ++ct)
#pragma unroll
      for (int g = 0; g < 4; ++g) {
        const float G = (sc[ct][4 * g] + sc[ct][4 * g + 1]) + (sc[ct][4 * g + 2] + sc[ct][4 * g + 3]);
        const float rcv = __shfl_xor(sc[ct][4 * g + 3], 32);
        const float extra = hh ? rcv : prev;
        imr[8 * ct + 2 * g + hh] = G + extra;
        prev = rcv;
      }
  }
  f32x16 o[2];
#pragma unroll
  for (int dt = 0; dt < 2; ++dt)
#pragma unroll
    for (int i = 0; i < 16; ++i) o[dt][i] = 0.f;
#pragma unroll
  for (int ct = 0; ct < 4; ++ct) {
    if (ct < nct) {
#pragma unroll
      for (int s2 = 0; s2 < 2; ++s2) {
        bf16x8 pf = PACK8(sc[ct], 8 * s2);
#pragma unroll
        for (int dt = 0; dt < 2; ++dt) {
          const bfu* vp = Vt + (32 * dt + r) * CVP + 32 * ct + 16 * s2 + 4 * hh;
          s16x4 lo4 = *(const s16x4*)vp;
          s16x4 hi4 = *(const s16x4*)(vp + 8);
          bf16x8 a = __builtin_shufflevector(lo4, hi4, 0, 1, 2, 3, 4, 5, 6, 7);
          o[dt] = MFMA(a, pf, o[dt]);
        }
      }
    }
  }
  {
    const float g0 = sigmoidf_(p.small_[t * 16 + 0 * 4 + h]);
    float* dst = p.ocmp + (t * 4 + h) * 64;
#pragma unroll
    for (int dt = 0; dt < 2; ++dt)
#pragma unroll
      for (int g = 0; g < 4; ++g)
        *(float4*)(dst + 32 * dt + 8 * g + 4 * hh) = make_float4(o[dt][4 * g] * g0, o[dt][4 * g + 1] * g0, o[dt][4 * g + 2] * g0, o[dt][4 * g + 3] * g0);
  }
  __syncthreads();
  {
    const int tk = tid >> 3, sub = tid & 7;
    float* i0 = impx + tk * 33;
#pragma unroll
    for (int q = 0; q < 4; ++q) {
      const int j = sub * 4 + q;
      i0[j] = (i0[j] + impx[(32 + tk) * 33 + j]) + (impx[(64 + tk) * 33 + j] + impx[(96 + tk) * 33 + j]);
    }
    __syncthreads();
    const int sp = s0 + tk;
    const int cur = sp >> 6;
    unsigned mask = 0;
#pragma unroll 1
    for (int q = 0; q < 4; ++q) {
      const int j = sub * 4 + q;
      if (j <= cur) {
        const bool fj = (j == 0) || (j == cur) || (j == cur - 1);
        const float vj = fj ? 1e9f : i0[j];
        int rank = 0;
        for (int i2 = 0; i2 <= cur; ++i2) {
          const bool fi = (i2 == 0) || (i2 == cur) || (i2 == cur - 1);
          const float vi = fi ? 1e9f : i0[i2];
          rank += (vi > vj || (vi == vj && i2 < j)) ? 1 : 0;
        }
        if (rank < 16) mask |= (1u << j);
      }
    }
    mask |= __shfl_xor(mask, 1); mask |= __shfl_xor(mask, 2); mask |= __shfl_xor(mask, 4);
    if (sub == 0) p.selmask[(size_t)b * S + sp] = mask;
  }
}

constexpr int VP = 72;
constexpr int AT_KS = 0, AT_VS = 13312, AT_CUM = 22528, AT_FLAGS = 22784, AT_OR = 22800, AT_LUT = 22816;

template <int MODE>
DI void attn_run(const bfu* __restrict__ Qp, const bfu* __restrict__ Kp, const bfu* __restrict__ Vtp, int qt,
                 f32x16 (&o)[2], const float* __restrict__ cump, unsigned sel, unsigned blockmask, char* smem) {
  constexpr int DK = (MODE == 1) ? 96 : 64;
  constexpr int KP = DK + 8;
  constexpr int NKS = DK / 16;
  constexpr int KCH = DK / 8;
  constexpr int NKC = 64 * KCH / 256;
  bfu* Ks = (bfu*)(smem + AT_KS);
  bfu* Vs = (bfu*)(smem + AT_VS);
  float* cumk = (float*)(smem + AT_CUM);
  int* flags = (int*)(smem + AT_FLAGS);
  const float* lut = (const float*)(smem + AT_LUT);
  const int tid = TID(), lane = tid & 63, w = tid >> 6, r = lane & 31, hh = lane >> 5;
  const int q0 = qt * 128;
  const int t = q0 + w * 32 + r;
  const int tw_min = q0 + w * 32, tw_max = tw_min + 31;
  bf16x8 qf[NKS];
#pragma unroll
  for (int ks = 0; ks < NKS; ++ks) qf[ks] = *(const bf16x8*)(Qp + (size_t)t * DK + ks * 16 + hh * 8);
  float cumq = 0.f;
  if (MODE == 2) cumq = cump[t];
  bf16x8 U[2];
  if (MODE == 0) {
#pragma unroll
    for (int s2 = 0; s2 < 2; ++s2)
#pragma unroll
      for (int j = 0; j < 8; ++j) { int kk = 16 * s2 + 8 * (j >> 2) + 4 * hh + (j & 3); U[s2][j] = (kk > r) ? (short)0x3F80 : (short)0; }
  }
#pragma unroll
  for (int dt = 0; dt < 2; ++dt)
#pragma unroll
    for (int i = 0; i < 16; ++i) o[dt][i] = 0.f;
  float m = -INFINITY, l = 0.f, carry = 0.f;

  int kt_lo = 0, kt_hi = 2 * qt + 1;
  if (MODE == 4) kt_lo = (2 * qt - 8) > 0 ? (2 * qt - 8) : 0;
  int kt;
  if (MODE == 0) kt = kt_hi;
  else if (MODE == 3) { kt = kt_lo; while (kt <= kt_hi && !((blockmask >> kt) & 1u)) ++kt; }
  else kt = kt_lo;
  u32x4 rk[NKC], rv[2]; float rc = 0.f;
#define ATT_LOAD(KT)                                                                                              \
  { const int k0_ = (KT) * 64;                                                                                    \
    _Pragma("unroll") for (int j = 0; j < NKC; ++j) { int c = tid + 256 * j; int row = c / KCH, kc = c % KCH;       \
      rk[j] = *(const u32x4*)(Kp + (size_t)(k0_ + row) * DK + kc * 8); }                                           \
    _Pragma("unroll") for (int j = 0; j < 2; ++j) { int c = tid + 256 * j; int d = c >> 3, kc = c & 7;              \
      rv[j] = *(const u32x4*)(Vtp + (size_t)d * S + k0_ + kc * 8); }                                               \
    if (MODE == 2) { if (tid < 64) rc = cump[k0_ + tid]; } }
  if (kt <= kt_hi && kt >= 0) { ATT_LOAD(kt) }
  while (kt >= kt_lo && kt <= kt_hi) {
    BAR_LDS();
    if (MODE == 0) { if (flags[0] && flags[1] && flags[2] && flags[3]) break; }
#pragma unroll
    for (int j = 0; j < NKC; ++j) { int c = tid + 256 * j; int row = c / KCH, kc = c % KCH; *(u32x4*)(Ks + row * KP + kc * 8) = rk[j]; }
#pragma unroll
    for (int j = 0; j < 2; ++j) { int c = tid + 256 * j; int d = c >> 3, kc = c & 7; *(u32x4*)(Vs + d * VP + kc * 8) = rv[j]; }
    if (MODE == 2) { if (tid < 64) cumk[tid] = rc; }
    BAR_LDS();
    int nkt;
    if (MODE == 0) nkt = kt - 1;
    else if (MODE == 3) { nkt = kt + 1; while (nkt <= kt_hi && !((blockmask >> nkt) & 1u)) ++nkt; }
    else nkt = kt + 1;
    { const int lk_ = (nkt >= kt_lo && nkt <= kt_hi) ? nkt : kt;
      ATT_LOAD(lk_) }
    const int k0 = kt * 64;
    bool active;
    if (MODE == 0) active = (k0 < tw_max);
    else if (MODE == 4) active = (k0 <= tw_max) && (k0 + 63 >= tw_min - 511);
    else active = (k0 <= tw_max);
    if (active) {
      f32x16 sc[2];
#pragma unroll
      for (int mt = 0; mt < 2; ++mt) {
#pragma unroll
        for (int i = 0; i < 16; ++i) sc[mt][i] = 0.f;
#pragma unroll
        for (int ks = 0; ks < NKS; ++ks) {
          bf16x8 a = *(const bf16x8*)(Ks + (32 * mt + r) * KP + ks * 16 + hh * 8);
          sc[mt] = MFMA(a, qf[ks], sc[mt]);
        }
      }
      if (MODE == 0) {
        f32x16 Lm[2]; float cs[2];
#pragma unroll
        for (int mt = 0; mt < 2; ++mt) {
          float c_ = 0.f;
#pragma unroll
          for (int i = 0; i < 16; ++i) {
            const int key = k0 + 32 * mt + (i & 3) + 8 * (i >> 2) + 4 * hh;
            const float z = sc[mt][i];
            const bool past = key < t;
            const float sp = fmaxf(z, 0.f) + __logf(1.f + __expf(-fabsf(z)));
            const float Lv = past ? -sp : 0.f;
            Lm[mt][i] = Lv; c_ += Lv;
            sc[mt][i] = past ? (z - sp) : -INFINITY;
          }
          c_ += __shfl_xor(c_, 32);
          cs[mt] = c_;
        }
#pragma unroll
        for (int mt = 0; mt < 2; ++mt) {
          f32x16 bt;
#pragma unroll
          for (int i = 0; i < 16; ++i) bt[i] = 0.f;
#pragma unroll
          for (int s2 = 0; s2 < 2; ++s2) {
            float lo8[8]; unsigned hb[8];
#pragma unroll
            for (int j = 0; j < 8; ++j) { float Lv = Lm[mt][8 * s2 + j]; bfu hbits = f2bf(Lv); hb[j] = hbits; lo8[j] = Lv - bf2f(hbits); }
            bf16x8 hi = __builtin_bit_cast(bf16x8, (u32x4){hb[0] | (hb[1] << 16), hb[2] | (hb[3] << 16), hb[4] | (hb[5] << 16), hb[6] | (hb[7] << 16)});
            bf16x8 lo = __builtin_bit_cast(bf16x8, (u32x4){pk2(lo8[0], lo8[1]), pk2(lo8[2], lo8[3]), pk2(lo8[4], lo8[5]), pk2(lo8[6], lo8[7])});
            bt = MFMA(U[s2], hi, bt);
            bt = MFMA(U[s2], lo, bt);
          }
          const float add = carry + (mt == 0 ? cs[1] : 0.f);
#pragma unroll
          for (int i = 0; i < 16; ++i) sc[mt][i] = __expf(sc[mt][i] + bt[i] + add);
        }
        carry += cs[0] + cs[1];
      } else {
        float mxv = -INFINITY;
        const bool need_mask = (MODE == 3) || (k0 + 63 > tw_min) || (MODE == 4 && (k0 < tw_max - 511));
        if (need_mask) {
#pragma unroll
          for (int mt = 0; mt < 2; ++mt)
#pragma unroll
            for (int i = 0; i < 16; ++i) {
              const int kl = 32 * mt + (i & 3) + 8 * (i >> 2) + 4 * hh;
              const int key = k0 + kl;
              float s = sc[mt][i];
              bool valid;
              if (MODE == 1) valid = key <= t;
              else if (MODE == 2) { valid = key <= t; s += cumq - cumk[kl]; }
              else {
                int dd = t - key;
                if (MODE == 3) valid = (dd >= 0) && ((sel >> kt) & 1u); else valid = (dd >= 0) && (dd < 512);
                int di = dd < 0 ? 0 : (dd > 128 ? 128 : dd);
                s += lut[di];
              }
              s = valid ? s : -INFINITY;
              sc[mt][i] = s; mxv = fmaxf(mxv, s);
            }
        } else {
#pragma unroll
          for (int mt = 0; mt < 2; ++mt)
#pragma unroll
            for (int i = 0; i < 16; ++i) {
              const int kl = 32 * mt + (i & 3) + 8 * (i >> 2) + 4 * hh;
              float s = sc[mt][i];
              if (MODE == 2) s += cumq - cumk[kl];
              if (MODE == 4) { int dd = t - (k0 + kl); s += lut[dd > 128 ? 128 : dd]; }
              sc[mt][i] = s; mxv = fmaxf(mxv, s);
            }
        }
        mxv = fmaxf(mxv, __shfl_xor(mxv, 32));
        const float m_new = fmaxf(m, mxv);
        const float m_use = (m_new == -INFINITY) ? 0.f : m_new;
        if (__any(m_new != m)) {
          const float alpha = __expf(m - m_use);
          l *= alpha;
#pragma unroll
          for (int dt = 0; dt < 2; ++dt)
#pragma unroll
            for (int i = 0; i < 16; ++i) o[dt][i] *= alpha;
        }
        const float mL = m_use * 1.4426950408889634f;
        float ps = 0.f;
#pragma unroll
        for (int mt = 0; mt < 2; ++mt)
#pragma unroll
          for (int i = 0; i < 16; ++i) { float pv = __builtin_amdgcn_exp2f(__builtin_fmaf(sc[mt][i], 1.4426950408889634f, -mL)); ps += pv; sc[mt][i] = pv; }
        l += ps; m = m_new;
      }
#pragma unroll
      for (int mt = 0; mt < 2; ++mt)
#pragma unroll
        for (int s2 = 0; s2 < 2; ++s2) {
          bf16x8 pf = PACK8(sc[mt], 8 * s2);
#pragma unroll
          for (int dt = 0; dt < 2; ++dt) {
            const bfu* vp = Vs + (32 * dt + r) * VP + 32 * mt + 16 * s2 + 4 * hh;
            s16x4 lo4 = *(const s16x4*)vp;
            s16x4 hi4 = *(const s16x4*)(vp + 8);
            bf16x8 a = __builtin_shufflevector(lo4, hi4, 0, 1, 2, 3, 4, 5, 6, 7);
            o[dt] = MFMA(a, pf, o[dt]);
          }
        }
    }
    if (MODE == 0) { int dn = __all(carry < -110.f) ? 1 : 0; if (lane == 0) flags[w] = dn; }
    kt = nkt;
  }
#undef ATT_LOAD
  if (MODE != 0) {
    l += __shfl_xor(l, 32);
    const float il = 1.f / l;
#pragma unroll
    for (int dt = 0; dt < 2; ++dt)
#pragma unroll
      for (int i = 0; i < 16; ++i) o[dt][i] *= il;
  }
}

DI void attn_store(bfu* __restrict__ yrow  , const f32x16 (&o)[2], int hh) {
#pragma unroll
  for (int dt = 0; dt < 2; ++dt)
#pragma unroll
    for (int g = 0; g < 4; ++g) {
      u32x2 v = {pk2(o[dt][4 * g], o[dt][4 * g + 1]), pk2(o[dt][4 * g + 2], o[dt][4 * g + 3])};
      *(u32x2*)(yrow + 32 * dt + 8 * g + 4 * hh) = v;
    }
}

template <int MODE>
DI void attn_item(const Params& p, int idx, char* smem) {
  const int tid = TID(), lane = tid & 63, w = tid >> 6, r = lane & 31, hh = lane >> 5;
  const int qt = 15 - (idx >> 5); const int bh = idx & 31, b = bh >> 2, h = bh & 3;
  const int spos = qt * 128 + w * 32 + r;
  const size_t t = (size_t)b * S + spos;
  __syncthreads();
  if (tid < 4) ((int*)(smem + AT_FLAGS))[tid] = 0;
  f32x16 o[2];
  if (MODE == 0) {
    attn_run<0>(p.q_sb + (size_t)bh * S * 64, p.k_sb + (size_t)bh * S * 64, p.vt_sb + (size_t)bh * 64 * S, qt, o, nullptr, 0u, 0u, smem);
    attn_store(p.y + t * 1024 + 0 * 256 + h * 64, o, hh);
  } else if (MODE == 1) {
    attn_run<1>(p.q_mla + (size_t)bh * S * 96, p.k_mla + (size_t)bh * S * 96, p.vt_mla + (size_t)bh * 64 * S, qt, o, nullptr, 0u, 0u, smem);
    attn_store(p.y + t * 1024 + 1 * 256 + h * 64, o, hh);
  } else if (MODE == 2) {
    attn_run<2>(p.q_fox + (size_t)bh * S * 64, p.k_fox + (size_t)bh * S * 64, p.vt_fox + (size_t)bh * 64 * S, qt, o, p.cum + (size_t)bh * S, 0u, 0u, smem);
    attn_store(p.y + t * 1024 + 3 * 256 + h * 64, o, hh);
  } else {
    float* lut = (float*)(smem + AT_LUT);
    unsigned* sor = (unsigned*)(smem + AT_OR);
    if (tid == 0) *sor = 0u;
    if (tid < 129) lut[tid] = p.rel_bias[rel_bucket_dev(tid) * 4 + h];
    __syncthreads();
    const unsigned sel = p.selmask[t];
    atomicOr(sor, sel);
    __syncthreads();
    const unsigned bm = *sor;
    attn_run<3>(p.q_nsa + (size_t)bh * S * 64, p.ks + (size_t)b * S * 64, p.vts + (size_t)b * 64 * S, qt, o, nullptr, sel, bm, smem);
    const float g1 = sigmoidf_(p.small_[t * 16 + 4 + h]);
    const float g2 = sigmoidf_(p.small_[t * 16 + 8 + h]);
    f32x16 tot[2];
    const float* oc = p.ocmp + (t * 4 + h) * 64;
#pragma unroll
    for (int dt = 0; dt < 2; ++dt)
#pragma unroll
      for (int g = 0; g < 4; ++g) {
        float4 c4 = *(const float4*)(oc + 32 * dt + 8 * g + 4 * hh);
        tot[dt][4 * g] = c4.x + g1 * o[dt][4 * g]; tot[dt][4 * g + 1] = c4.y + g1 * o[dt][4 * g + 1];
        tot[dt][4 * g + 2] = c4.z + g1 * o[dt][4 * g + 2]; tot[dt][4 * g + 3] = c4.w + g1 * o[dt][4 * g + 3];
      }
    attn_run<4>(p.q_nsa + (size_t)bh * S * 64, p.kw + (size_t)b * S * 64, p.vtw + (size_t)b * 64 * S, qt, o, nullptr, 0u, 0u, smem);
#pragma unroll
    for (int dt = 0; dt < 2; ++dt)
#pragma unroll
      for (int i = 0; i < 16; ++i) tot[dt][i] += g2 * o[dt][i];
    attn_store(p.y + t * 1024 + 2 * 256 + h * 64, tot, hh);
  }
}

DI void phase_attn1(const Params& p, int L, char* smem) {
  const int extra = (L > 0) ? CV_NC : 0;
  for (int it = blockIdx.x; it < 1792 + extra; it += gridDim.x) {
    if (it < 512) attn_item<2>(p, it, smem);
    else if (it < 1024) nsacmp_item(p, L, it - 512, smem);
    else if (it < 1536) attn_item<0>(p, it - 1024, smem);
    else if (it < 1792) mlaprep_item(p, L, it - 1536, smem);
    else conv_item_C(p, L, it - 1792, smem);
  }
}
DI void phase_attn2(const Params& p, char* smem) {
  for (int it = blockIdx.x; it < 1024; it += gridDim.x) {
    const int j = (it & 511) >> 1;
    const int idx = (it < 512) ? j : (511 - j);
    if (it & 1) attn_item<1>(p, idx, smem); else attn_item<3>(p, idx, smem);
  }
}

DI void phase_widen(const Params& p, char* smem) {
  GEMM_IDS
  for (int id = blockIdx.x; id < 128 * 8; id += gridDim.x) {
    int tm, tn; map_tile(id, 8, tm, tn);
    const int m0 = tm * 128, n0 = tn * 128;
    f32x16 tot[2][2]; ZERO_ACC(tot)
    f32x16 acc[2][2]; ZERO_ACC(acc)
    auto flush = [&](int n) {
      EPI_BEGIN(acc) tot[mt][nt][i] += v * bf2f(p.gates[(size_t)row * 4096 + n * 1024 + col]); acc[mt][nt][i] = 0.f; EPI_END
    };
    gemm_core_h<false, false, 2, 4>(p.y, 1024, p.wt_br, 1024, 1024, m0, n0, acc, smem, flush);
    EPI_BEGIN(tot) p.u[(size_t)row * 1024 + col] = f2bf(v); EPI_END
  }
}
DI void phase_resid(const Params& p, const bfu* A, int lda, const bfu* Bt, int K, char* smem) {
  GEMM_IDS
  for (int id = blockIdx.x; id < 64 * 8; id += gridDim.x) {
    int tm, tn; map_tile(id, 8, tm, tn);
    const int m0 = tm * 256, n0 = tn * 128;
    f32x16 acc[4][2]; ZERO_ACCM(acc, 4)
    gemm_core<false, false, 4>(A, lda, Bt, K, K, m0, n0, acc, smem);
    EPI_BEGINM(acc, 4)
      float* xp = p.out + (size_t)row * 1024 + col;
      float nv = *xp + v; *xp = nv; p.xb[(size_t)row * 1024 + col] = f2bf(nv);
    EPI_END
  }
}
DI void phase_up(const Params& p, char* smem) {
  GEMM_IDS
  for (int id = blockIdx.x; id < 64 * 32; id += gridDim.x) {
    int tm, tn; map_tile(id, 32, tm, tn);
    const int m0 = tm * 256, n0 = tn * 128;
    f32x16 acc[4][2]; ZERO_ACCM(acc, 4)
    gemm_core<true, false, 4>(p.xb, D, p.wt_up, D, D, m0, n0, acc, smem);
    STORE_TILE_BF16(acc, 4, p.ff, DFF, 0, fmaxf(v * rs, 0.f) * fmaxf(v * rs, 0.f))
  }
}
DI void phase_ple(const Params& p, int L, char* smem) {
  GEMM_IDS
  for (int id = blockIdx.x; id < 128 * 8; id += gridDim.x) {
    int tm, tn; map_tile(id, 8, tm, tn);
    const int m0 = tm * 128, n0 = tn * 128;
    f32x16 gt[2][2]; ZERO_ACC(gt)
    gemm_core<true>(p.xb, D, p.wt_pg, D, D, m0, n0, gt, smem);
    EPI_BEGIN(gt) gt[mt][nt][i] = sigmoidf_(v * rstd_s[rl]); EPI_END
    f32x16 acc[2][2]; ZERO_ACC(acc)
    gemm_core<false, false>(p.pb, 256, p.wt_pp, 256, 256, m0, n0, acc, smem);
    EPI_BEGIN(acc)
      float* xp = p.out + (size_t)row * 1024 + col;
      float nv = *xp + gt[mt][nt][i] * v; *xp = nv; p.xb2[(size_t)row * 1024 + col] = f2bf(nv);
    EPI_END
  }
  if (L + 1 < 4) {
    __syncthreads();
    for (int it = blockIdx.x; it < CV_NA + CV_NB; it += gridDim.x) {
      if (it < CV_NA) conv_item_A(p, L + 1, it, smem); else conv_item_B(p, L + 1, it - CV_NA, smem);
    }
  }
}

DI void grid_barrier() { cg::this_grid().sync(); }
DI void grid_barrier_light(unsigned* ctr, unsigned target) {
  asm volatile("s_waitcnt vmcnt(0)" ::: "memory");
  __syncthreads();
  if (TID() == 0) {
    __builtin_amdgcn_fence(__ATOMIC_RELEASE, "agent");
    asm volatile("s_waitcnt vmcnt(0)" ::: "memory");
    __hip_atomic_fetch_add(ctr, 1u, __ATOMIC_RELAXED, __HIP_MEMORY_SCOPE_AGENT);
    while (__hip_atomic_load(ctr, __ATOMIC_RELAXED, __HIP_MEMORY_SCOPE_AGENT) < target) __builtin_amdgcn_s_sleep(1);
    __builtin_amdgcn_fence(__ATOMIC_ACQUIRE, "agent");
    asm volatile("s_waitcnt vmcnt(0)" ::: "memory");
  }
  __syncthreads();
}

__global__ void __launch_bounds__(256, 2) hybrid_megakernel(Params p) {
  __shared__ __attribute__((aligned(16))) char smem[SMEM_BYTES];
  unsigned epoch = 0;
  for (int ph = p.ph_lo; ph < p.ph_hi; ++ph) {
    const int L = ph / NPH, s = ph % NPH;
    if (s == 0 && L > 0) continue;
#ifdef ONLY
    if (s != ONLY) continue;
#endif
    switch (s) {
      case 0: phase_convert(p, L, smem); break;
      case 1: phase_in(p, L, smem); break;
      case 2: phase_prep(p, L, smem); break;
      case 3: phase_attn1(p, L, smem); break;
      case 4: phase_attn2(p, smem); break;
      case 5: phase_widen(p, smem); break;
      case 6: phase_resid(p, p.u, 1024, p.wt_o, 1024, smem); break;
      case 7: phase_up(p, smem); break;
      case 8: phase_resid(p, p.ff, DFF, p.wt_down, DFF, smem); break;
      case 9: phase_ple(p, L, smem); break;
    }
    if (ph + 1 < p.ph_hi) {
      if (ph == p.ph_lo) grid_barrier();
      else { ++epoch; grid_barrier_light(p.bar, epoch * gridDim.x); }
    }
  }
}

extern "C" void kernel_launch(void* const* d_in, const int* in_sizes, int n_in, void* d_out, int out_size, void* d_ws,
                              size_t ws_size, hipStream_t stream) {
  Params p;
  memset(&p, 0, sizeof(p));
  const float* const* in = (const float* const*)d_in;
  p.x = in[0]; p.p = in[1]; p.rel_bias = in[2]; p.norm_mix_g = in[3]; p.w_in = in[4]; p.mla_cq_g = in[5]; p.mla_ckv_g = in[6];
  p.mla_w_uq = in[7]; p.mla_w_ukv = in[8]; p.mla_qn_g = in[9]; p.mla_kn_g = in[10]; p.nsa_pe_k = in[11]; p.nsa_pe_v = in[12];
  p.nsa_w1_k = in[13]; p.nsa_w2_k = in[14]; p.nsa_w1_v = in[15]; p.nsa_w2_v = in[16]; p.nsa_qn_g = in[17]; p.nsa_kn_g = in[18];
  p.fox_f_bias = in[19]; p.fox_qn_g = in[20]; p.fox_kn_g = in[21]; p.w_branch = in[22]; p.w_o = in[23]; p.norm_mlp_g = in[24];
  p.w_up = in[25]; p.w_down = in[26]; p.norm_ple_g = in[27]; p.w_ple_gate = in[28]; p.w_ple_proj = in[29];
  p.out = (float*)d_out;
  char* ws = (char*)d_ws; size_t off = 0;
  auto take = [&](size_t bytes) { char* r = ws + off; off += (bytes + 255) & ~(size_t)255; return r; };
  p.wt_in = (bfu*)take((size_t)NINP * D * 2);
  p.wt_uq = (bfu*)take(384 * 384 * 2);
  p.wt_ukv = (bfu*)take(512 * 128 * 2);
  p.wt_br = (bfu*)take((size_t)4 * D * 256 * 2);
  p.wt_o = (bfu*)take((size_t)D * D * 2);
  p.wt_up = (bfu*)take((size_t)DFF * D * 2);
  p.wt_down = (bfu*)take((size_t)D * DFF * 2);
  p.wt_pg = (bfu*)take((size_t)D * D * 2);
  p.wt_pp = (bfu*)take((size_t)D * 256 * 2);
  p.xb = (bfu*)take((size_t)M * D * 2);
  p.pb = (bfu*)take((size_t)M * 256 * 2);
  char* projr = take((size_t)M * PJ * 2);
  p.proj = (bfu*)projr;
  p.cq = p.xb; p.ckv = p.xb + (size_t)M * 384;
  p.gates = (bfu*)take((size_t)M * 4096 * 2);
  p.ff = p.gates;
  p.y = (bfu*)take((size_t)M * D * 2);
  p.qraw = (bfu*)take((size_t)M * 384 * 2);
  p.kvraw = (bfu*)take((size_t)M * 512 * 2);
  p.small_ = (float*)take((size_t)M * 16 * 4);
  p.kcmp = (bfu*)take((size_t)(M + 32) * 64 * 2); p.vcmp = (bfu*)take((size_t)(M + 32) * 64 * 2);
  p.wt_w1 = (bfu*)take((size_t)2 * 128 * 2048 * 2);
  p.pebias = (float*)take(16 * 64 * 4);
  p.krope = (bfu*)take((size_t)M * 32 * 2);
  p.xb2 = p.y;
  p.q_sb = (bfu*)take((size_t)M * 256 * 2); p.k_sb = (bfu*)take((size_t)M * 256 * 2); p.vt_sb = (bfu*)take((size_t)M * 256 * 2);
  p.q_fox = (bfu*)take((size_t)M * 256 * 2); p.k_fox = (bfu*)take((size_t)M * 256 * 2); p.vt_fox = (bfu*)take((size_t)M * 256 * 2);
  p.q_nsa = (bfu*)take((size_t)M * 256 * 2);
  p.ks = (bfu*)take((size_t)M * 64 * 2); p.vts = (bfu*)take((size_t)M * 64 * 2); p.kw = (bfu*)take((size_t)M * 64 * 2); p.vtw = (bfu*)take((size_t)M * 64 * 2);
  p.cum = (float*)take((size_t)NB * H * S * 4);
  p.kc = (float*)take((size_t)NB * 128 * 64 * 4); p.vc = (float*)take((size_t)NB * 128 * 64 * 4);
  p.kc_b = (bfu*)take((size_t)NB * 128 * 64 * 2); p.vct_b = (bfu*)take((size_t)NB * 64 * 128 * 2);
  p.selmask = (unsigned*)take((size_t)M * 4);
  p.bar = (unsigned*)take(256);
  {
    size_t o2 = 0;
    p.u = (bfu*)(projr + o2); o2 += (size_t)M * D * 2;
    p.q_mla = (bfu*)(projr + o2); o2 += (size_t)M * 384 * 2;
    p.k_mla = (bfu*)(projr + o2); o2 += (size_t)M * 384 * 2;
    p.vt_mla = (bfu*)(projr + o2); o2 += (size_t)M * 256 * 2;
    p.ocmp = (float*)(projr + o2); o2 += (size_t)M * 256 * 4;
    if (o2 > (size_t)M * PJ * 2) fprintf(stderr, "alias overflow\n");
  }
  if (off > ws_size) fprintf(stderr, "workspace too small: need %zu have %zu\n", off, ws_size);

  static int grid_blocks = 0;
  if (!grid_blocks) {
    int dev = 0, cus = 0, per_cu = 0;
    hipGetDevice(&dev);
    hipDeviceGetAttribute(&cus, hipDeviceAttributeMultiprocessorCount, dev);
    hipOccupancyMaxActiveBlocksPerMultiprocessor(&per_cu, hybrid_megakernel, 256, 0);
    if (per_cu > 2) per_cu = 2;
    if (per_cu < 1) per_cu = 1;
    grid_blocks = cus * per_cu;
  }
#if MULTI
  for (int ph = 0; ph < 4 * NPH; ++ph) {
    p.ph_lo = ph; p.ph_hi = ph + 1;
    hipLaunchKernelGGL(hybrid_megakernel, dim3(grid_blocks), dim3(256), 0, stream, p);
  }
#else
  p.ph_lo = 0; p.ph_hi = 4 * NPH;
  hipMemsetAsync(p.bar, 0, 256, stream);
  void* args[] = {&p};
  hipError_t e = hipLaunchCooperativeKernel((void*)hybrid_megakernel, dim3(grid_blocks), dim3(256), args, 0, stream);
  if (e != hipSuccess) fprintf(stderr, "cooperative launch failed: %s (grid %d)\n", hipGetErrorString(e), grid_blocks);
#endif
}
```
